# Optimizing an MI355X kernel written in HIP

```python
import jax
import jax.numpy as jnp
from jax import lax
import numpy as np

D_MODEL = 1024
BATCH = 32
SEQ = 256
DEPTH = 2
DEC_BATCH = 2
DEC_SEQ = 4096
PAST_LEN = 512

GRID_W = 64
POS_BASE = 10000.0
N_MIXERS = 4
D_MIX = D_MODEL
GROUP_W = D_MIX // N_MIXERS
N_DIRS = 2
CHUNK = 16
EPS = 1e-6
N_MOD = 6
GLA_HEADS = 4
GLA_DK = GROUP_W // GLA_HEADS
GLA_DV = GROUP_W // GLA_HEADS
GLA_LOWRANK = 16
GLA_GATE_TEMP = 16.0
RG_BLOCKS = 4
RG_BLOCK_W = GROUP_W // RG_BLOCKS
RG_CONV_W = 4
RG_C = 8.0
HY_ORDER = 2
HY_SHORT_W = 3
HY_POS_BANDS = 16
HY_POS_DIM = 2 * HY_POS_BANDS + 1
HY_FFN_W = 64
HY_DECAY_MIN = 3.07
HY_DECAY_MAX = 15.35
HG_HEADS = 4
HG_DK = GROUP_W // HG_HEADS
HG_DV = GROUP_W // HG_HEADS
D_FF = -(-(8 * D_MODEL) // (3 * 256)) * 256

IN_SPLITS = (GROUP_W, GROUP_W, GROUP_W, GROUP_W, GLA_LOWRANK,
             GROUP_W, GROUP_W,
             (HY_ORDER + 1) * GROUP_W,
             GROUP_W, GROUP_W, GROUP_W, GROUP_W, GROUP_W)
IN_OFFSETS = tuple(int(o) for o in np.cumsum(IN_SPLITS)[:-1])
D_IN = int(sum(IN_SPLITS))

kernel_name = 'hybrid_diffusion_gla_rglru_hyena_hgrn2_step'

F32 = jnp.float32


def rmsnorm(x, g):
    xf = x.astype(F32)
    y = xf * lax.rsqrt(jnp.mean(xf * xf, axis=-1, keepdims=True) + EPS)
    return (y * g.astype(F32)).astype(x.dtype)


def split_heads(t, n_heads):
    return t.reshape(t.shape[:-1] + (n_heads, t.shape[-1] // n_heads))


def head_rmsnorm_gate(o, gain, gate):
    o = o * lax.rsqrt(jnp.mean(o * o, axis=-1, keepdims=True) + EPS)
    o = o.reshape(o.shape[:2] + (-1,)) * gain.astype(F32)
    return (o * jax.nn.silu(gate.astype(F32))).astype(gate.dtype)


def depthwise_conv(x, w, b, pad_left):
    width, ch = w.shape
    y = lax.conv_general_dilated(x, w[:, None, :], (1,), [(pad_left, width - 1 - pad_left)],
                                 dimension_numbers=('NWC', 'WIO', 'NWC'), feature_group_count=ch)
    return y + b


def grid_position_embedding(n_tokens, dim):
    rows = n_tokens // GRID_W
    row = jnp.broadcast_to(jnp.arange(rows, dtype=F32)[:, None], (rows, GRID_W)).reshape(-1)
    col = jnp.broadcast_to(jnp.arange(GRID_W, dtype=F32)[None, :], (rows, GRID_W)).reshape(-1)
    quarter = dim // 4
    omega = 1.0 / (POS_BASE ** (jnp.arange(quarter, dtype=F32) / quarter))

    def enc(pos):
        ang = pos[:, None] * omega[None, :]
        return jnp.concatenate([jnp.sin(ang), jnp.cos(ang)], axis=-1)

    return jnp.concatenate([enc(row), enc(col)], axis=-1)


def chunked_gated_state(q, k, v, log_a, s0):
    B, L, H, _ = q.shape
    V = v.shape[-1]
    n = L // CHUNK

    def chunks(t):
        return t.astype(F32).reshape(B, n, CHUNK, H, t.shape[-1]).transpose(1, 0, 3, 2, 4)

    qc, kc, vc, ac = chunks(q), chunks(k), chunks(v), chunks(log_a)
    b = jnp.cumsum(ac, axis=3)
    causal = jnp.tril(jnp.ones((CHUNK, CHUNK), dtype=bool))
    rel = jnp.where(causal[:, :, None], b[:, :, :, :, None, :] - b[:, :, :, None, :, :], -jnp.inf)
    scores = jnp.einsum('nbhtk,nbhsk,nbhtsk->nbhts', qc, kc, jnp.exp(rel))
    o_intra = jnp.einsum('nbhts,nbhsv->nbhtv', scores, vc)
    b_end = b[:, :, :, -1:, :]
    q_dec = qc * jnp.exp(b)
    kv = jnp.einsum('nbhck,nbhcv->nbhkv', kc * jnp.exp(b_end - b), vc)
    decay_end = jnp.exp(b_end[:, :, :, 0, :])

    def step(S, inp):
        qd, dec, kv_c = inp
        o = jnp.einsum('bhck,bhkv->bhcv', qd, S)
        return dec[..., None] * S + kv_c, o

    s_final, o_inter = lax.scan(step, s0.astype(F32), (q_dec, decay_end, kv))
    o = (o_intra + o_inter).transpose(1, 0, 3, 2, 4).reshape(B, L, H, V)
    return o, s_final


def diag_linear_scan(a, u, h0):
    def combine(e1, e2):
        a1, b1 = e1
        a2, b2 = e2
        return a1 * a2, a2 * b1 + b2

    a_cum, u_cum = lax.associative_scan(combine, (a, u), axis=1)
    h = a_cum * h0[:, None, :] + u_cum
    return h, h[:, -1]


def gla_mixer(q, k, v, g, lr, w_gate, b_gate, norm_g, s0):
    qh = split_heads(q, GLA_HEADS) * GLA_DK ** -0.5
    kh = split_heads(k, GLA_HEADS)
    vh = split_heads(v, GLA_HEADS)
    outs, finals = [], []
    for d in range(N_DIRS):
        log_a = jax.nn.log_sigmoid((lr @ w_gate[d] + b_gate[d]).astype(F32)) / GLA_GATE_TEMP
        seq = (qh, kh, vh, split_heads(log_a, GLA_HEADS))
        if d == 1:
            seq = tuple(jnp.flip(t, axis=1) for t in seq)
        o, s_f = chunked_gated_state(*seq, s0[:, d])
        outs.append(o if d == 0 else jnp.flip(o, axis=1))
        finals.append(s_f)
    return head_rmsnorm_gate(outs[0] + outs[1], norm_g, g), jnp.stack(finals, axis=1)


def rglru_mixer(xb, gb, conv_w, conv_b, w_a, b_a, w_x, b_x, lam, h0):
    B, L, C = xb.shape
    xc = depthwise_conv(xb, conv_w, conv_b, RG_CONV_W // 2)
    xblk = split_heads(xc, RG_BLOCKS)
    xf = xc.astype(F32)
    outs, finals = [], []
    for d in range(N_DIRS):
        r = jax.nn.sigmoid((jnp.einsum('blhi,hij->blhj', xblk, w_a[d]).reshape(B, L, C) + b_a[d]).astype(F32))
        i = jax.nn.sigmoid((jnp.einsum('blhi,hij->blhj', xblk, w_x[d]).reshape(B, L, C) + b_x[d]).astype(F32))
        log_a = -RG_C * r * jax.nn.softplus(-lam[d].astype(F32))
        a = jnp.exp(log_a)
        u = jnp.sqrt(-jnp.expm1(2.0 * log_a)) * (i * xf)
        if d == 1:
            a, u = jnp.flip(a, axis=1), jnp.flip(u, axis=1)
        h, h_last = diag_linear_scan(a, u, h0[:, d].astype(F32))
        outs.append(h if d == 0 else jnp.flip(h, axis=1))
        finals.append(h_last)
    y = (outs[0] + outs[1]) * jax.nn.gelu(gb.astype(F32))
    return y.astype(xb.dtype), jnp.stack(finals, axis=1)


def hyena_filters(L, w1, b1, w2, b2, w3, decay_rate):
    pos = jnp.arange(L, dtype=F32)
    t = pos / (L - 1)
    ang = (2.0 * jnp.pi * pos / L)[:, None] * jnp.linspace(1e-4, HY_POS_BANDS - 1, HY_POS_BANDS, dtype=F32)[None, :]
    pe = jnp.concatenate([t[:, None], jnp.cos(ang), -jnp.sin(ang)], axis=-1)
    h = jnp.sin(pe @ w1.astype(F32) + b1.astype(F32))
    h = jnp.sin(h @ w2.astype(F32) + b2.astype(F32))
    h = h @ w3.astype(F32)
    half = L // 2
    dist = jnp.abs(pos - half) / half
    h = h * jnp.exp(-dist[:, None] * decay_rate.astype(F32)[None, :])
    return h / jnp.sum(jnp.abs(h), axis=0, keepdims=True)


def fft_long_conv(z, h):
    L = z.shape[1]
    n_fft = 2 * L
    zf = jnp.fft.rfft(z, n=n_fft, axis=1)
    hf = jnp.fft.rfft(h, n=n_fft, axis=0)
    full = jnp.fft.irfft(zf * hf[None], n=n_fft, axis=1)
    return full[:, L // 2: L // 2 + L]


def hyena_mixer(proj, conv_w, conv_b, w1, b1, w2, b2, w3, decay_rate, skip):
    L = proj.shape[1]
    uc = depthwise_conv(proj, conv_w, conv_b, HY_SHORT_W // 2).astype(F32)
    v, x1, x2 = jnp.split(uc, HY_ORDER + 1, axis=-1)
    filt = hyena_filters(L, w1, b1, w2, b2, w3, decay_rate)
    skip = skip.astype(F32)
    z = v
    for n, gate in enumerate((x1, x2)):
        sl = slice(n * GROUP_W, (n + 1) * GROUP_W)
        z = gate * (fft_long_conv(z, filt[:, sl]) + skip[sl] * z)
    return z.astype(proj.dtype)


def hgrn2_mixer(q, f_fwd, f_bwd, i, g, lb, norm_g, s0):
    qh = split_heads(jax.nn.silu(q.astype(F32)), HG_HEADS)
    vh = split_heads(i, HG_HEADS)
    log_lb, log_1m_lb = jnp.log(lb), jnp.log1p(-lb)
    outs, finals = [], []
    for d, fl in enumerate((f_fwd, f_bwd)):
        fl = fl.astype(F32)
        log_f = jnp.logaddexp(log_lb, log_1m_lb + jax.nn.log_sigmoid(fl))
        k = (1.0 - lb) * jax.nn.sigmoid(-fl)
        seq = (qh, split_heads(k, HG_HEADS), vh, split_heads(log_f, HG_HEADS))
        if d == 1:
            seq = tuple(jnp.flip(t, axis=1) for t in seq)
        o, s_f = chunked_gated_state(*seq, s0[:, d])
        outs.append(o if d == 0 else jnp.flip(o, axis=1))
        finals.append(s_f)
    return head_rmsnorm_gate(outs[0] + outs[1], norm_g, g), jnp.stack(finals, axis=1)


def token_mixers(u, p, s_gla, s_rg, s_hg):
    proj = u @ p['w_in']
    (a_q, a_k, a_v, a_g, a_lr, b_x, b_g, c_in, d_q, d_ff, d_fb, d_i, d_g) = jnp.split(proj, IN_OFFSETS, axis=-1)
    y_a, st_a = gla_mixer(a_q, a_k, a_v, a_g, a_lr, p['gla_w_gate'], p['gla_b_gate'], p['gla_norm_g'], s_gla)
    y_b, st_b = rglru_mixer(b_x, b_g, p['rg_conv_w'], p['rg_conv_b'], p['rg_w_a'], p['rg_b_a'],
                            p['rg_w_x'], p['rg_b_x'], p['rg_lambda'], s_rg)
    y_c = hyena_mixer(c_in, p['hy_conv_w'], p['hy_conv_b'], p['hy_w1'], p['hy_b1'], p['hy_w2'],
                      p['hy_b2'], p['hy_w3'], p['hy_decay'], p['hy_skip'])
    y_d, st_d = hgrn2_mixer(d_q, d_ff, d_fb, d_i, d_g, p['hg_lb'], p['hg_norm_g'], s_hg)
    mixed = jnp.concatenate([y_a, y_b, y_c, y_d], axis=-1) @ p['w_out']
    return mixed, (st_a.astype(u.dtype), st_b.astype(u.dtype), st_d.astype(u.dtype))


def trunk_layer(x, mod, p, s_gla, s_rg, s_hg):
    sh1, sc1, g1, sh2, sc2, g2 = jnp.split(mod, N_MOD, axis=-1)
    u = rmsnorm(x, p['norm1_g']) * (1 + sc1) + sh1
    mixed, finals = token_mixers(u, p, s_gla, s_rg, s_hg)
    x = x + g1 * mixed
    u = rmsnorm(x, p['norm2_g']) * (1 + sc2) + sh2
    hidden = jax.nn.silu(u @ p['ffn_w1']) * (u @ p['ffn_w3'])
    x = x + g2 * (hidden @ p['ffn_w2'])
    return x, finals


def setup_inputs(seed: int = 0) -> dict:
    key = jax.random.key(seed)
    keys = iter(jax.random.split(key, 64))

    def nrm(shape, scale=1.0):
        return scale * jax.random.normal(next(keys), shape, F32)

    def gain(shape):
        return 1.0 + nrm(shape, 0.02)

    D, W, NL = D_MODEL, GROUP_W, DEPTH
    u = jax.random.uniform(next(keys), (NL, N_DIRS, W), F32, 0.9, 0.999)
    a_base = u ** (1.0 / RG_C)
    rg_lambda = jnp.log(a_base) - jnp.log1p(-a_base)
    hy_decay = (jnp.tile(jnp.linspace(HY_DECAY_MIN, HY_DECAY_MAX, W, dtype=F32), (NL, HY_ORDER))
                + nrm((NL, HY_ORDER * W), 0.1))
    return {
        'x_prompt': nrm((BATCH, SEQ, D)),
        'x_sample': nrm((DEC_BATCH, DEC_SEQ, D)),
        'state_gla': nrm((DEC_BATCH, NL, N_DIRS, GLA_HEADS, GLA_DK, GLA_DV), 0.5),
        'state_rglru': nrm((DEC_BATCH, NL, N_DIRS, W), 0.5),
        'state_hgrn': nrm((DEC_BATCH, NL, N_DIRS, HG_HEADS, HG_DK, HG_DV), 0.5),
        'c': nrm((DEC_BATCH, D)),
        'c_ctx': nrm((D,)),
        'norm1_g': gain((NL, D)),
        'norm2_g': gain((NL, D)),
        'final_norm_g': gain((D,)),
        'w_mod': nrm((NL, D, N_MOD * D), 0.5 * D ** -0.5),
        'b_mod': nrm((NL, N_MOD * D), 0.02),
        'w_in': nrm((NL, D, D_IN), D ** -0.5),
        'w_out': nrm((NL, D_MIX, D), D_MIX ** -0.5),
        'gla_w_gate': nrm((NL, N_DIRS, GLA_LOWRANK, W), GLA_LOWRANK ** -0.5),
        'gla_b_gate': nrm((NL, N_DIRS, W), 0.1),
        'gla_norm_g': gain((NL, W)),
        'rg_conv_w': nrm((NL, RG_CONV_W, W), RG_CONV_W ** -0.5),
        'rg_conv_b': nrm((NL, W), 0.02),
        'rg_w_a': nrm((NL, N_DIRS, RG_BLOCKS, RG_BLOCK_W, RG_BLOCK_W), RG_BLOCK_W ** -0.5),
        'rg_b_a': nrm((NL, N_DIRS, W), 0.1),
        'rg_w_x': nrm((NL, N_DIRS, RG_BLOCKS, RG_BLOCK_W, RG_BLOCK_W), RG_BLOCK_W ** -0.5),
        'rg_b_x': nrm((NL, N_DIRS, W), 0.1),
        'rg_lambda': rg_lambda,
        'hy_conv_w': nrm((NL, HY_SHORT_W, (HY_ORDER + 1) * W), HY_SHORT_W ** -0.5),
        'hy_conv_b': nrm((NL, (HY_ORDER + 1) * W), 0.02),
        'hy_w1': nrm((NL, HY_POS_DIM, HY_FFN_W), HY_POS_DIM ** -0.5),
        'hy_b1': nrm((NL, HY_FFN_W), 0.1),
        'hy_w2': nrm((NL, HY_FFN_W, HY_FFN_W), HY_FFN_W ** -0.5),
        'hy_b2': nrm((NL, HY_FFN_W), 0.1),
        'hy_w3': nrm((NL, HY_FFN_W, HY_ORDER * W), HY_FFN_W ** -0.5),
        'hy_decay': hy_decay,
        'hy_skip': nrm((NL, HY_ORDER * W)),
        'hg_lower': nrm((NL, W), 0.1),
        'hg_norm_g': gain((NL, W)),
        'ffn_w1': nrm((NL, D, D_FF), D ** -0.5),
        'ffn_w3': nrm((NL, D, D_FF), D ** -0.5),
        'ffn_w2': nrm((NL, D_FF, D), D_FF ** -0.5),
    }


def reference(x_prompt, x_sample, state_gla, state_rglru, state_hgrn, c, c_ctx,
              norm1_g, norm2_g, final_norm_g, w_mod, b_mod, w_in, w_out,
              gla_w_gate, gla_b_gate, gla_norm_g,
              rg_conv_w, rg_conv_b, rg_w_a, rg_b_a, rg_w_x, rg_b_x, rg_lambda,
              hy_conv_w, hy_conv_b, hy_w1, hy_b1, hy_w2, hy_b2, hy_w3, hy_decay, hy_skip,
              hg_lower, hg_norm_g, ffn_w1, ffn_w3, ffn_w2):
    n_ctx_req = x_prompt.shape[0]
    hg_lb = jnp.cumsum(jax.nn.softmax(hg_lower.astype(F32), axis=0), axis=0)
    hg_lb = hg_lb - hg_lb[0:1]
    xp = x_prompt
    xs = x_sample + grid_position_embedding(x_sample.shape[1], x_sample.shape[2]).astype(x_sample.dtype)[None]
    zero_gla = jnp.zeros((n_ctx_req, N_DIRS, GLA_HEADS, GLA_DK, GLA_DV), x_prompt.dtype)
    zero_rg = jnp.zeros((n_ctx_req, N_DIRS, GROUP_W), x_prompt.dtype)
    zero_hg = jnp.zeros((n_ctx_req, N_DIRS, HG_HEADS, HG_DK, HG_DV), x_prompt.dtype)
    gla_states, rg_states, hg_states = [], [], []
    for l in range(DEPTH):
        p = dict(norm1_g=norm1_g[l], norm2_g=norm2_g[l], w_in=w_in[l], w_out=w_out[l],
                 gla_w_gate=gla_w_gate[l], gla_b_gate=gla_b_gate[l], gla_norm_g=gla_norm_g[l],
                 rg_conv_w=rg_conv_w[l], rg_conv_b=rg_conv_b[l], rg_w_a=rg_w_a[l], rg_b_a=rg_b_a[l],
                 rg_w_x=rg_w_x[l], rg_b_x=rg_b_x[l], rg_lambda=rg_lambda[l],
                 hy_conv_w=hy_conv_w[l], hy_conv_b=hy_conv_b[l], hy_w1=hy_w1[l], hy_b1=hy_b1[l],
                 hy_w2=hy_w2[l], hy_b2=hy_b2[l], hy_w3=hy_w3[l], hy_decay=hy_decay[l], hy_skip=hy_skip[l],
                 hg_lb=hg_lb[l], hg_norm_g=hg_norm_g[l],
                 ffn_w1=ffn_w1[l], ffn_w3=ffn_w3[l], ffn_w2=ffn_w2[l])
        mod_ctx = (jax.nn.silu(c_ctx)[None, :] @ w_mod[l] + b_mod[l])[:, None, :]
        mod_lat = (jax.nn.silu(c) @ w_mod[l] + b_mod[l])[:, None, :]
        xp, (sg, sr, sh) = trunk_layer(xp, mod_ctx, p, zero_gla, zero_rg, zero_hg)
        xs, _ = trunk_layer(xs, mod_lat, p, state_gla[:, l], state_rglru[:, l], state_hgrn[:, l])
        gla_states.append(sg)
        rg_states.append(sr)
        hg_states.append(sh)
    y_prompt = rmsnorm(xp, final_norm_g)
    y_sample = rmsnorm(xs, final_norm_g)
    new_state_gla = jnp.stack(gla_states, axis=1)
    new_state_rglru = jnp.stack(rg_states, axis=1)
    new_state_hgrn = jnp.stack(hg_states, axis=1)
    return (y_prompt, y_sample, new_state_gla, new_state_rglru, new_state_hgrn)
```

```cpp
#include <hip/hip_runtime.h>
#include <cstdio>
#include <cstdint>
#include <cmath>
namespace pg8 {
#define PG8_LAS __attribute__((address_space(3)))
typedef unsigned short bf16_t;
typedef short bf16x8 __attribute__((ext_vector_type(8)));
typedef float f32x4 __attribute__((ext_vector_type(4)));
typedef unsigned u32x4 __attribute__((ext_vector_type(4)));
constexpr int BM = 256, BK = 64, HALF = 128, HTB = HALF * BK * 2  , STAGE_BYTES = 8 * HTB, NXCD = 8, WGM = 8;

__host__ __device__ __forceinline__ int lds_byte(int r, int c) { const int st = (r >> 4) * 2 + (c >> 5), rr = r & 15, cc = c & 31, ob = rr * 64 + cc * 2; return st * 1024 + (ob ^ (((ob >> 9) & 1) << 5)); }
__host__ __device__ __forceinline__ void stage_rc(int b, int& R, int& C) { const int st = b / 1024, sb = b % 1024, swz = sb ^ (((sb >> 9) & 1) << 5); R = (st >> 1) * 16 + swz / 64; C = (st & 1) * 32 + (swz % 64) / 2; }
__host__ __device__ __forceinline__ int perm32(int rho) { const int n = rho >> 4, i = rho & 15; return 8 * (i >> 2) + 4 * n + (i & 3); }

struct Unit { int pm, pn; };
struct Gemm { const bf16_t* A; const bf16_t* Bt; int M, N, K; };

struct StaticOrder {
    int nM, nN, nwg, G, c;
    __host__ __device__ void init(int M, int N, int G_, int c_) { nM = M / BM; nN = N / BM; nwg = nM * nN; G = G_; c = c_; }
    __host__ __device__ bool next(int i, Unit& u) const {
        const long L = (long)i * G + c; if (L >= nwg) return false;
        int wgid = (int)L; { const int q = nwg / NXCD, r = nwg % NXCD, xcd = wgid % NXCD, off = wgid / NXCD; wgid = (xcd < r ? xcd * (q + 1) : r * (q + 1) + (xcd - r) * q) + off; }
        const int nig = WGM * nN, gid = wgid / nig, fm = gid * WGM, gsz = (nM - fm) < WGM ? (nM - fm) : WGM;
        u.pm = fm + ((wgid % nig) % gsz); u.pn = (wgid % nig) / gsz; return true;
    }
    __device__ __forceinline__ void a_ready(const Unit&) const {}
    __device__ __forceinline__ void done(const Unit&) const {}
};
__device__ __forceinline__ unsigned cvt_pk_bf16(float lo, float hi) { unsigned r; asm volatile("v_cvt_pk_bf16_f32 %0, %1, %2" : "=v"(r) : "v"(lo), "v"(hi)); return r; }
typedef float f32x2 __attribute__((ext_vector_type(2)));
constexpr int PROJ_LD = 2848;
struct EpiProj {
    static constexpr bool PERM = true, AFTER_DRAIN = false;
    bf16_t* PROJ; bf16_t* CT; bf16_t* CT2;
    __device__ __forceinline__ void operator()(const f32x4 (&acc)[2][2][4][2], const Unit& u, int wr, int wc, int fr, int fq) const {
        const int row0 = u.pm * BM + wr * 64 + fr;
        if (u.pn >= 3) {
            const bool lrt = (u.pn == 14);
            if (lrt && !(wc == 0 && fq < 2)) return;
            const unsigned voff0 = (unsigned)row0 * (unsigned)PROJ_LD + (unsigned)((u.pn - 3) * 256 + wc * 32 + 8 * fq);
#pragma unroll
            for (int ai = 0; ai < 2; ++ai)
#pragma unroll
                for (int m = 0; m < 4; ++m) { unsigned voff = voff0 + (unsigned)((ai * HALF + m * 16) * PROJ_LD); asm volatile("" : "+v"(voff));
#pragma unroll
                    for (int bj = 0; bj < 2; ++bj) { if (lrt && bj == 1) continue;
                        const f32x4 v0 = acc[ai][bj][m][0], v1 = acc[ai][bj][m][1];
                        u32x4 w; w.x = cvt_pk_bf16(v0[0], v0[1]); w.y = cvt_pk_bf16(v0[2], v0[3]); w.z = cvt_pk_bf16(v1[0], v1[1]); w.w = cvt_pk_bf16(v1[2], v1[3]);
                        *(u32x4*)(PROJ + voff + bj * HALF) = w; } }
        } else {
            bf16_t* base = (u.pn == 0) ? CT : (u.pn == 1) ? CT + 8192 : CT2;
            const unsigned cs = (u.pn == 2) ? 16384u : 32768u;
            const unsigned rofs = (u.pn == 2) ? (unsigned)row0 : ((unsigned)(row0 & 8191) + ((row0 >> 13) ? 16384u : 0u));
            const unsigned voff0 = (unsigned)(wc * 32 + 8 * fq) * cs + rofs;
#pragma unroll
            for (int bj = 0; bj < 2; ++bj)
#pragma unroll
                for (int n = 0; n < 2; ++n)
#pragma unroll
                    for (int e = 0; e < 4; e += 2) { unsigned voff = voff0 + (unsigned)(bj * HALF + 4 * n + e) * cs; asm volatile("" : "+v"(voff)); unsigned voff1 = voff + cs; asm volatile("" : "+v"(voff1));
#pragma unroll
                        for (int ai = 0; ai < 2; ++ai)
#pragma unroll
                            for (int m = 0; m < 4; ++m) { const unsigned w = cvt_pk_bf16(acc[ai][bj][m][n][e], acc[ai][bj][m][n][e + 1]);
                                base[voff + ai * HALF + m * 16] = (bf16_t)(w & 0xffffu); base[voff1 + ai * HALF + m * 16] = (bf16_t)(w >> 16); }
                        asm volatile("" ::: "memory"); }
        }
    }
};
struct EpiResid {
    static constexpr bool PERM = false, AFTER_DRAIN = false;
    float* X; const float* gate3;
    __device__ __forceinline__ void operator()(const f32x4 (&acc)[2][2][4][2], const Unit& u, int wr, int wc, int fr, int fq) const {
        const int r = (u.pm < 32) ? 0 : 1 + ((u.pm - 32) >> 4);
        const float* g = gate3 + r * 6144;
        const int col0 = u.pn * BM + wc * 32 + 4 * fq;
        f32x4 gv[2][2];
#pragma unroll
        for (int bj = 0; bj < 2; ++bj)
#pragma unroll
            for (int n = 0; n < 2; ++n) gv[bj][n] = *(const f32x4*)(g + col0 + bj * HALF + n * 16);
#pragma unroll
        for (int ai = 0; ai < 2; ++ai)
#pragma unroll
            for (int m = 0; m < 4; ++m) { float* rowp = X + (size_t)(u.pm * BM + ai * HALF + wr * 64 + m * 16 + fr) * 1024 + col0;
#pragma unroll
                for (int bj = 0; bj < 2; ++bj)
#pragma unroll
                    for (int n = 0; n < 2; ++n) { f32x4* p = (f32x4*)(rowp + bj * HALF + n * 16); const f32x4 x = *p; *p = x + gv[bj][n] * acc[ai][bj][m][n]; } }
    }
};
struct EpiSwiGLU {
    static constexpr bool PERM = true, AFTER_DRAIN = false;
    bf16_t* HID; int ldh;
    __device__ __forceinline__ void operator()(const f32x4 (&acc)[2][2][4][2], const Unit& u, int wr, int wc, int fr, int fq) const {
        const int row0 = u.pm * BM + wr * 64 + fr, col0 = u.pn * HALF + wc * 32 + 8 * fq;
#pragma unroll
        for (int ai = 0; ai < 2; ++ai)
#pragma unroll
            for (int m = 0; m < 4; ++m) { float h[8];
#pragma unroll
                for (int n = 0; n < 2; ++n)
#pragma unroll
                    for (int e = 0; e < 4; ++e) { const float a = acc[ai][0][m][n][e], b = acc[ai][1][m][n][e]; h[4 * n + e] = a * b * __builtin_amdgcn_rcpf(1.f + __expf(-a)); }
                u32x4 w; w.x = cvt_pk_bf16(h[0], h[1]); w.y = cvt_pk_bf16(h[2], h[3]); w.z = cvt_pk_bf16(h[4], h[5]); w.w = cvt_pk_bf16(h[6], h[7]);
                *(u32x4*)(HID + (size_t)(row0 + ai * HALF + m * 16) * ldh + col0) = w; }
    }
};
template <class Epi, class Sched, bool ALIGN_EPI = false, bool SP2 = false>
__device__ __forceinline__ void gemm_phase(PG8_LAS unsigned char* lds, const Gemm g, const Sched& S, const Epi& E) {
    const int tid = threadIdx.x, wid = __builtin_amdgcn_readfirstlane(tid >> 6), lane = tid & 63, wr = wid >> 2, wc = wid & 3, fr = lane & 15, fq = lane >> 4;
    const int K = g.K, nt = K / BK;
    unsigned voffA[2], voffB[2];
#pragma unroll
    for (int i = 0; i < 2; ++i) { int R, C; stage_rc(tid * 16 + i * 8192, R, C); const int Rb = Epi::PERM ? ((R & ~31) + perm32(R & 31)) : R;
        voffA[i] = (unsigned)(R * K + C) * 2u; voffB[i] = (unsigned)(Rb * K + C) * 2u; }
    const size_t kstep = (size_t)(BK * 2);
    const size_t hstep = (size_t)HALF * K * 2;
    const size_t tstep = 2 * hstep;
    const unsigned ldsw = (unsigned)wid * 1024u;
    const int aoff = lds_byte(wr * 64 + fr, fq * 8), boff = lds_byte(wc * 32 + fr, fq * 8);
#define PG8_SA(b, h) (((b) * 2 + (h)) * HTB)
#define PG8_SB(b, h) ((4 + (b) * 2 + (h)) * HTB)
#define PG8_STAGE(bufoff, gbase, voff) do { _Pragma("unroll") for (int _i = 0; _i < 2; ++_i) \
        __builtin_amdgcn_global_load_lds((const unsigned*)((const char*)(gbase) + (voff)[_i]), (PG8_LAS unsigned*)(lds + (bufoff) + ldsw + _i * 8192), 16, 0, 0); } while (0)
#define PG8_LDA(dst, b, h) do { _Pragma("unroll") for (int m = 0; m < 4; ++m) _Pragma("unroll") for (int k = 0; k < 2; ++k) dst[m][k] = *(const PG8_LAS bf16x8*)(lds + PG8_SA(b, h) + aoff + m * 2048 + k * 1024); } while (0)
#define PG8_LDB(dst, b, h) do { _Pragma("unroll") for (int n = 0; n < 2; ++n) _Pragma("unroll") for (int k = 0; k < 2; ++k) dst[n][k] = *(const PG8_LAS bf16x8*)(lds + PG8_SB(b, h) + boff + n * 2048 + k * 1024); } while (0)
#define PG8_MMA(ai, bj, At, Bt) do { __builtin_amdgcn_s_setprio(1); _Pragma("unroll") for (int m = 0; m < 4; ++m) _Pragma("unroll") for (int n = 0; n < 2; ++n) _Pragma("unroll") for (int k = 0; k < 2; ++k) \
        acc[ai][bj][m][n] = __builtin_amdgcn_mfma_f32_16x16x32_bf16(Bt[n][k], At[m][k], acc[ai][bj][m][n], 0, 0, 0); __builtin_amdgcn_s_setprio(0); } while (0)
#define PG8_WAIT_V(n) asm volatile("s_waitcnt vmcnt(" #n ")" ::: "memory")
#define PG8_WAIT_L(n) asm volatile("s_waitcnt lgkmcnt(" #n ")" ::: "memory")
#define PG8_BAR __builtin_amdgcn_s_barrier()
#define PG8_SCHED __builtin_amdgcn_sched_barrier(0)
    Unit cur, nxt; int ui = 0;
    if (!S.next(0, cur)) return;
    f32x4 acc[2][2][4][2];
#pragma unroll
    for (int a = 0; a < 2; ++a)
#pragma unroll
        for (int b = 0; b < 2; ++b)
#pragma unroll
            for (int m = 0; m < 4; ++m)
#pragma unroll
                for (int n = 0; n < 2; ++n) acc[a][b][m][n] = (f32x4){0.f, 0.f, 0.f, 0.f};
    bf16x8 At[4][2], B0[2][2], B1[2][2];
    const char* cA = (const char*)g.A + (size_t)cur.pm * tstep; const char* cB = (const char*)g.Bt + (size_t)cur.pn * tstep;
    S.a_ready(cur);
    if constexpr (SP2) {
        PG8_STAGE(PG8_SB(0, 0), cB, voffB); PG8_STAGE(PG8_SB(0, 1), cB + hstep, voffB); PG8_STAGE(PG8_SA(0, 0), cA, voffA); PG8_STAGE(PG8_SA(0, 1), cA + hstep, voffA);
        if (wr == 1) PG8_BAR;
        PG8_WAIT_V(2); PG8_BAR;
        PG8_STAGE(PG8_SB(1, 0), cB + kstep, voffB); PG8_STAGE(PG8_SA(1, 0), cA + kstep, voffA); PG8_STAGE(PG8_SB(1, 1), cB + hstep + kstep, voffB);
        PG8_WAIT_V(6); PG8_BAR;
    } else {
        PG8_STAGE(PG8_SB(0, 0), cB, voffB); PG8_STAGE(PG8_SA(0, 0), cA, voffA); PG8_STAGE(PG8_SB(0, 1), cB + hstep, voffB); PG8_STAGE(PG8_SA(0, 1), cA + hstep, voffA);
        if (wr == 1) PG8_BAR;
        PG8_WAIT_V(4); PG8_BAR;
        PG8_STAGE(PG8_SB(1, 0), cB + kstep, voffB); PG8_STAGE(PG8_SA(1, 0), cA + kstep, voffA); PG8_STAGE(PG8_SB(1, 1), cB + hstep + kstep, voffB);
        PG8_WAIT_V(6); PG8_BAR;
    }
    for (;;) {
        const bool has_next = S.next(ui + 1, nxt);
        const char* nA = has_next ? (const char*)g.A + (size_t)nxt.pm * tstep : cA; const char* nB = has_next ? (const char*)g.Bt + (size_t)nxt.pn * tstep : cB;
        for (int t = 0; t < nt; t += 2) {
            const bool last = (t == nt - 2);
            const char* a1 = cA + (size_t)(t + 1) * kstep;
            const char* a2 = last ? nA : cA + (size_t)(t + 2) * kstep; const char* b2 = last ? nB : cB + (size_t)(t + 2) * kstep;
            const char* a3 = a2 + kstep; const char* b3 = b2 + kstep;
            if (last && has_next) S.a_ready(nxt);
            if constexpr (SP2) {
            PG8_LDB(B0, 0, 0); PG8_LDB(B1, 0, 1); PG8_SCHED; PG8_LDA(At, 0, 0); PG8_STAGE(PG8_SA(1, 1), a1 + hstep, voffA);
            PG8_WAIT_V(8); PG8_WAIT_L(0); PG8_BAR; PG8_MMA(0, 0, At, B0); PG8_MMA(0, 1, At, B1); PG8_BAR; PG8_SCHED;
            PG8_LDA(At, 0, 1); PG8_STAGE(PG8_SB(0, 0), b2, voffB); PG8_STAGE(PG8_SB(0, 1), b2 + hstep, voffB); PG8_STAGE(PG8_SA(0, 0), a2, voffA);
            PG8_WAIT_V(8); PG8_WAIT_L(0); PG8_BAR; PG8_MMA(1, 0, At, B0); PG8_MMA(1, 1, At, B1); PG8_BAR; PG8_SCHED;
            PG8_LDB(B0, 1, 0); PG8_LDB(B1, 1, 1); PG8_SCHED; PG8_LDA(At, 1, 0); PG8_STAGE(PG8_SA(0, 1), a2 + hstep, voffA);
            PG8_WAIT_V(8); PG8_WAIT_L(0); PG8_BAR; PG8_MMA(0, 0, At, B0); PG8_MMA(0, 1, At, B1); PG8_BAR; PG8_SCHED;
            PG8_LDA(At, 1, 1); PG8_STAGE(PG8_SB(1, 0), b3, voffB); PG8_STAGE(PG8_SB(1, 1), b3 + hstep, voffB); PG8_STAGE(PG8_SA(1, 0), a3, voffA);
            PG8_WAIT_V(8); PG8_WAIT_L(0); PG8_BAR; PG8_MMA(1, 0, At, B0); PG8_MMA(1, 1, At, B1); PG8_BAR; PG8_SCHED;
            } else {
            PG8_LDB(B0, 0, 0); PG8_SCHED; PG8_LDA(At, 0, 0); PG8_STAGE(PG8_SA(1, 1), a1 + hstep, voffA);
            PG8_WAIT_L(8); PG8_BAR; PG8_WAIT_L(0); PG8_MMA(0, 0, At, B0); PG8_BAR; PG8_SCHED;
            PG8_LDB(B1, 0, 1); PG8_STAGE(PG8_SB(0, 0), b2, voffB);
            PG8_BAR; PG8_WAIT_L(0); PG8_MMA(0, 1, At, B1); PG8_BAR;
            PG8_LDA(At, 0, 1); PG8_STAGE(PG8_SA(0, 0), a2, voffA);
            PG8_BAR; PG8_WAIT_L(0); PG8_MMA(1, 0, At, B0); PG8_BAR; PG8_SCHED;
            PG8_STAGE(PG8_SB(0, 1), b2 + hstep, voffB);
            PG8_WAIT_V(6); PG8_BAR; PG8_MMA(1, 1, At, B1); PG8_BAR;
            PG8_LDB(B0, 1, 0); PG8_SCHED; PG8_LDA(At, 1, 0); PG8_STAGE(PG8_SA(0, 1), a2 + hstep, voffA);
            PG8_WAIT_L(8); PG8_BAR; PG8_WAIT_L(0); PG8_MMA(0, 0, At, B0); PG8_BAR; PG8_SCHED;
            PG8_LDB(B1, 1, 1); PG8_STAGE(PG8_SB(1, 0), b3, voffB);
            PG8_BAR; PG8_WAIT_L(0); PG8_MMA(0, 1, At, B1); PG8_BAR;
            PG8_LDA(At, 1, 1); PG8_STAGE(PG8_SA(1, 0), a3, voffA);
            PG8_BAR; PG8_WAIT_L(0); PG8_MMA(1, 0, At, B0); PG8_BAR; PG8_SCHED;
            PG8_STAGE(PG8_SB(1, 1), b3 + hstep, voffB);
            PG8_WAIT_V(6); PG8_BAR; PG8_MMA(1, 1, At, B1); PG8_BAR;
            }
        }
        if constexpr (ALIGN_EPI) { if (wr == 0) PG8_BAR; }
        if constexpr (!Epi::AFTER_DRAIN) { E(acc, cur, wr, wc, fr, fq); S.done(cur); }
        if (!has_next) break;
#pragma unroll
        for (int a = 0; a < 2; ++a)
#pragma unroll
            for (int b = 0; b < 2; ++b)
#pragma unroll
                for (int m = 0; m < 4; ++m)
#pragma unroll
                    for (int n = 0; n < 2; ++n) acc[a][b][m][n] = (f32x4){0.f, 0.f, 0.f, 0.f};
        cur = nxt; cA = nA; cB = nB; ++ui;
        if constexpr (ALIGN_EPI) { if (wr == 1) PG8_BAR; }
    }
    PG8_WAIT_V(0);
    if constexpr (!ALIGN_EPI) { if (wr == 0) PG8_BAR; }
    PG8_BAR;
    if constexpr (Epi::AFTER_DRAIN) { E.fused(acc, cur, wr, wc, fr, fq, lds, wid, lane); S.done(cur); }
#undef PG8_SA
#undef PG8_SB
#undef PG8_STAGE
#undef PG8_LDA
#undef PG8_LDB
#undef PG8_MMA
#undef PG8_WAIT_V
#undef PG8_WAIT_L
#undef PG8_BAR
#undef PG8_SCHED
}
}
constexpr int NWAVES = 8;
constexpr int D = 1024, M = 16384, MCTX = 8192, DFF = 2816, NIN = 3840, DIN = 3600;
constexpr float EPS = 1e-6f;
constexpr size_t MiB = 1u << 20;
constexpr size_t WS_CTL = 0, CTL_ZERO_BYTES = MiB;
constexpr size_t WS_MOD = 1 * MiB;
constexpr size_t WS_PE = WS_MOD + 147456;
constexpr size_t WS_RGW = WS_PE + 131072;
constexpr size_t WS_RGAGG = WS_RGW + 262144;
constexpr size_t WS_GD = WS_RGAGG + 131072;
static_assert(WS_GD + 131072 <= 2 * MiB, "small region");
constexpr size_t WS_H2 = 2 * MiB;
constexpr size_t WS_HT = 5 * MiB;
constexpr size_t WS_HTC = 21 * MiB;
constexpr size_t WS_WIN = 22 * MiB, WS_WOUT = WS_WIN + (size_t)NIN * D * 2, WS_W13 = WS_WOUT + (size_t)D * D * 2, WS_W2 = WS_W13 + (size_t)2 * DFF * D * 2;
static_assert(WS_W2 + (size_t)D * DFF * 2 == 48 * MiB, "weights fill [22,48) MiB");
constexpr size_t WS_XN = 48 * MiB;
constexpr size_t WS_PROJ = 80 * MiB;
constexpr size_t WS_CT = 169 * MiB, WS_CT2 = 185 * MiB;
constexpr size_t WS_OSUM = 193 * MiB;
constexpr size_t WS_RGH = 225 * MiB, WS_RGP = 233 * MiB;
constexpr size_t WS_GS = 241 * MiB, WS_END = 249 * MiB;
constexpr size_t OUT_YS = 8388608, OUT_SGLA = 16777216, OUT_SRG = 18874368, OUT_SHG = 18907136, OUT_END = 21004288;
constexpr int CW_BAR = 4096;
constexpr int RING_BYTES = 131072, LDS_BYTES = 147456, LDSCTL_OFF = LDS_BYTES - 512, MISC_OFF = LDSCTL_OFF + 320;

#define GAS __attribute__((address_space(1)))
#define LAS __attribute__((address_space(3)))
typedef unsigned short bf16;
typedef unsigned v4u __attribute__((ext_vector_type(4)));
typedef unsigned v2u __attribute__((ext_vector_type(2)));
typedef float f32x4 __attribute__((ext_vector_type(4)));
typedef float f32x2 __attribute__((ext_vector_type(2)));
typedef short bf16x8 __attribute__((ext_vector_type(8)));
typedef short bf16x4 __attribute__((ext_vector_type(4)));
typedef GAS unsigned gu32;
#define RLX_AGENT __ATOMIC_RELAXED, __HIP_MEMORY_SCOPE_AGENT
#define LDS_WAIT() asm volatile("s_waitcnt lgkmcnt(0)" ::: "memory")
#define VM_WAIT() asm volatile("s_waitcnt vmcnt(0)" ::: "memory")
__device__ __forceinline__ unsigned f2bf(float f) { unsigned u = __builtin_bit_cast(unsigned, f); return (u + 0x7fffu + ((u >> 16) & 1u)) >> 16; }
__device__ __forceinline__ unsigned pk2(float lo, float hi) { return f2bf(lo) | (f2bf(hi) << 16); }
__device__ __forceinline__ float bf2f(unsigned h) { return __builtin_bit_cast(float, h << 16); }
__device__ __forceinline__ float bflo(unsigned w) { return __builtin_bit_cast(float, w << 16); }
__device__ __forceinline__ float bfhi(unsigned w) { return __builtin_bit_cast(float, w & 0xffff0000u); }
__device__ __forceinline__ float wave_sum(float v) {
#pragma unroll
    for (int o = 1; o < 64; o <<= 1) v += __shfl_xor(v, o);
    return v;
}
__device__ __forceinline__ float sigmoidf_(float x) { return 1.f / (1.f + __expf(-x)); }
#define XB_TMO      128
#define XB_XCNT(j)  (256  + 64 * (j))
#define XB_XSUB(j)  (1280 + 64 * (j))
#define XB_XGEN(j)  (2304 + 64 * (j))
#define XB_TOP      3328
#define XB_TOPGEN   3392
#define XCD_BAR_WORDS 3456
#define XB_SPIN_CAP (1u << 18)

__device__ __forceinline__ unsigned xb_ld(unsigned* p)              { return __hip_atomic_load(p, __ATOMIC_RELAXED, __HIP_MEMORY_SCOPE_AGENT); }
__device__ __forceinline__ unsigned xb_add(unsigned* p, unsigned v) { return __hip_atomic_fetch_add(p, v, __ATOMIC_RELAXED, __HIP_MEMORY_SCOPE_AGENT); }
__device__ __forceinline__ unsigned xb_xcc_id() { return (unsigned)__builtin_amdgcn_s_getreg((3 << 11) | 20) & 0xFu; }
#define XB_SPIN(cond, bar) do { unsigned _sp = 0; while (cond) { __builtin_amdgcn_s_sleep(1); \
    if ((++_sp & 255u) == 0u) { if (xb_ld(&(bar)[XB_TMO])) break; if (_sp > XB_SPIN_CAP) { atomicAdd(&(bar)[XB_TMO], 1u); break; } } } } while (0)

struct XcdBarrier {
    unsigned* bar; unsigned x;
    volatile LAS unsigned* st;
};

__device__ __forceinline__ XcdBarrier xcd_barrier_post(unsigned* bar, volatile LAS unsigned* st) {
    XcdBarrier b; b.bar = bar; b.x = xb_xcc_id(); b.st = st;
    if (threadIdx.x == 0) (void)xb_add(&bar[XB_XCNT(b.x)], 1u);
    return b;
}
__device__ __forceinline__ void xcd_barrier_complete(unsigned* bar, unsigned x, unsigned& nloc, unsigned& nx) {
    const unsigned G = gridDim.x * gridDim.y * gridDim.z;
    unsigned sum, cnt, mine, sp = 0u;
    for (;;) {
        sum = 0u; cnt = 0u; mine = 0u;
#pragma unroll
        for (unsigned j = 0; j < 16; ++j) { const unsigned c = xb_ld(&bar[XB_XCNT(j)]); sum += c; cnt += (c > 0u) ? 1u : 0u; mine = (j == x) ? c : mine; }
        if (sum == G) break;
        __builtin_amdgcn_s_sleep(1);
        if ((++sp & 255u) == 0u) { if (xb_ld(&bar[XB_TMO])) break; if (sp > XB_SPIN_CAP) { atomicAdd(&bar[XB_TMO], 1u); break; } }
    }
    nloc = mine > 0u ? mine : 1u; nx = cnt > 0u ? cnt : 1u;
}

__device__ __forceinline__ void xcd_barrier(const XcdBarrier& b) {
    asm volatile("s_waitcnt vmcnt(0)" ::: "memory");
    __syncthreads();
    if (threadIdx.x == 0) {
        unsigned* bar = b.bar;
        __builtin_amdgcn_s_waitcnt(0);
        unsigned nloc = b.st[0], nx = b.st[1];
        if (nloc == 0u) { xcd_barrier_complete(bar, b.x, nloc, nx); b.st[0] = nloc; b.st[1] = nx; }
        const unsigned old = xb_add(&bar[XB_XSUB(b.x)], 1u);
        const unsigned gen = old / nloc;
        if (old + 1u == (gen + 1u) * nloc) {
            __builtin_amdgcn_fence(__ATOMIC_RELEASE, "agent");
            asm volatile("s_waitcnt vmcnt(0)" ::: "memory");
            const unsigned og = xb_add(&bar[XB_TOP], 1u);
            const unsigned tg = og / nx;
            if (og + 1u == (tg + 1u) * nx) xb_add(&bar[XB_TOPGEN], 1u);
            else XB_SPIN(xb_ld(&bar[XB_TOPGEN]) == tg, bar);
            __builtin_amdgcn_fence(__ATOMIC_ACQUIRE, "agent");
            xb_add(&bar[XB_XGEN(b.x)], 1u);
            asm volatile("s_waitcnt vmcnt(0)" ::: "memory");
        } else {
            XB_SPIN(xb_ld(&bar[XB_XGEN(b.x)]) == gen, bar);
            __builtin_amdgcn_fence(__ATOMIC_ACQUIRE, "agent");
            asm volatile("s_waitcnt vmcnt(0)" ::: "memory");
        }
    }
    __syncthreads();
}
struct Ctx { LAS unsigned char* lds; int tid, lane, wave, vcu, G; };
typedef const float* fptr_t;
#define KARG ((const __attribute__((address_space(4))) fptr_t*)__builtin_amdgcn_kernarg_segment_ptr())
#define INP(i) (KARG[(i)])
#define OUTP ((float*)KARG[N_IN])
#define WSP ((unsigned char*)KARG[N_IN + 1])
enum { I_XP = 0, I_XS, I_SGLA, I_SRG, I_SHG, I_C, I_CCTX, I_N1G, I_N2G, I_FNG, I_WMOD, I_BMOD, I_WIN, I_WOUT, I_GLAWG, I_GLABG, I_GLANG,
       I_RGCW, I_RGCB, I_RGWA, I_RGBA, I_RGWX, I_RGBX, I_RGLAM, I_HYCW, I_HYCB, I_HYW1, I_HYB1, I_HYW2, I_HYB2, I_HYW3, I_HYDEC, I_HYSKIP,
       I_HGLOW, I_HGNG, I_FW1, I_FW3, I_FW2, N_IN };

__device__ __forceinline__ void transpose_tile(const float* W, int ldw, int k0, int c0, int nvalid, bf16* WT, int ldt, int r0, LAS float* scr, int lane) {
    const int n_ = lane & 31;
#pragma unroll 8
    for (int i = 0; i < 32; ++i) { const int kk = 2 * i + (lane >> 5); scr[kk * 33 + n_] = (n_ < nvalid) ? W[(size_t)(k0 + kk) * ldw + c0 + n_] : 0.f; }
    LDS_WAIT(); asm volatile("" ::: "memory");
    const int c = lane & 7;
#pragma unroll
    for (int j = 0; j < 4; ++j) { const int n = (lane >> 3) + 8 * j; const LAS float* s = scr + (8 * c) * 33 + n;
        v4u o; o.x = pk2(s[0 * 33], s[1 * 33]); o.y = pk2(s[2 * 33], s[3 * 33]); o.z = pk2(s[4 * 33], s[5 * 33]); o.w = pk2(s[6 * 33], s[7 * 33]);
        *(GAS v4u*)(WT + (size_t)(r0 + n) * ldt + k0 + 8 * c) = o; }
    LDS_WAIT(); asm volatile("" ::: "memory");
}
__device__ __forceinline__ void convert_weights(const Ctx& C, int l) {
    LAS float* scr = (LAS float*)(C.lds + C.wave * 16384);
    const int gw = C.vcu * NWAVES + C.wave, NGW = C.G * NWAVES;
    constexpr int I_IN = 16 * 120, I_OUT = 16 * 32, I_13 = 16 * 176, I_2 = 44 * 32, NITEMS = I_IN + I_OUT + I_13 + I_2;
    const float* win = INP(I_WIN) + (size_t)l * D * DIN; const float* wout = INP(I_WOUT) + (size_t)l * D * D;
    const float* w1 = INP(I_FW1) + (size_t)l * D * DFF; const float* w3 = INP(I_FW3) + (size_t)l * D * DFF; const float* w2 = INP(I_FW2) + (size_t)l * DFF * D;
    bf16* WinT = (bf16*)(WSP + WS_WIN); bf16* WoutT = (bf16*)(WSP + WS_WOUT); bf16* W13T = (bf16*)(WSP + WS_W13); bf16* W2T = (bf16*)(WSP + WS_W2);
    for (int it = gw; it < NITEMS; it += NGW) {
        int r = it;
        if (r < I_IN) { const int kb = r / 120, nb = r % 120, n0 = 32 * nb; int src, nv = 32;
            if (n0 < 768) src = 1552 + n0; else if (n0 < 1792) src = n0 - 768; else if (n0 < 2304) src = 1040 + (n0 - 1792); else if (n0 < 3584) src = 2320 + (n0 - 2304);
            else if (n0 == 3584) { src = 1024; nv = 16; } else { src = 0; nv = 0; }
            transpose_tile(win, DIN, 64 * kb, src, nv, WinT, D, n0, scr, C.lane); continue; } r -= I_IN;
        if (r < I_OUT) { const int kb = r / 32, nb = r % 32; transpose_tile(wout, D, 64 * kb, 32 * nb, 32, WoutT, D, 32 * nb, scr, C.lane); continue; } r -= I_OUT;
        if (r < I_13) { const int kb = r / 176, nb = r % 176, n0 = 32 * nb, tile = n0 >> 8, j = n0 & 255;
            transpose_tile(j < 128 ? w1 : w3, DFF, 64 * kb, 128 * tile + (j & 127), 32, W13T, D, n0, scr, C.lane); continue; } r -= I_13;
        { const int kb = r / 32, nb = r % 32; transpose_tile(w2, D, 64 * kb, 32 * nb, 32, W2T, DFF, 32 * nb, scr, C.lane); }
    }
}
__device__ __forceinline__ void mod_gemv(const Ctx& C) {
    LAS float* sc = (LAS float*)C.lds;
    LAS float* red = sc + 3072;
    for (int i = C.tid; i < 3072; i += NWAVES * 64) { const int r = i >> 10, k = i & 1023; const float v = (r == 0) ? INP(I_CCTX)[k] : INP(I_C)[(r - 1) * 1024 + k]; sc[i] = v * sigmoidf_(v); }
    __syncthreads();
    float* mod = (float*)(WSP + WS_MOD);
    for (int item = C.vcu; item < 192; item += C.G) {
        const int l = item / 96, col = (item % 96) * 64 + C.lane;
        const float* w = INP(I_WMOD) + (size_t)l * 1024 * 6144 + col;
        float a0 = 0.f, a1 = 0.f, a2 = 0.f;
        const int kb = C.wave * 128;
#pragma unroll 8
        for (int k = kb; k < kb + 128; ++k) { const float wv = w[(size_t)k * 6144]; a0 += sc[k] * wv; a1 += sc[1024 + k] * wv; a2 += sc[2048 + k] * wv; }
        red[(C.wave * 3 + 0) * 64 + C.lane] = a0; red[(C.wave * 3 + 1) * 64 + C.lane] = a1; red[(C.wave * 3 + 2) * 64 + C.lane] = a2;
        __syncthreads();
        if (C.tid < 192) { const int r = C.tid >> 6, c = C.tid & 63; float s = 0.f;
#pragma unroll
            for (int w8 = 0; w8 < 8; ++w8) s += red[(w8 * 3 + r) * 64 + c];
            const int cc = (item % 96) * 64 + c;
            mod[((size_t)l * 3 + r) * 6144 + cc] = s + INP(I_BMOD)[l * 6144 + cc]; }
        __syncthreads();
    }
}
__device__ __forceinline__ void h2_rows(const Ctx& C) {
    const int gw = C.vcu * NWAVES + C.wave, NGW = C.G * NWAVES;
    float* H2 = (float*)(WSP + WS_H2);
    for (int rw = gw; rw < 2 * 4352; rw += NGW) {
        const int l = rw / 4352, rr = rw % 4352; const int L = rr < 4096 ? 4096 : 256, pos = rr < 4096 ? rr : rr - 4096;
        float pe = 0.f;
        if (C.lane == 0) pe = (float)pos / (float)(L - 1);
        else if (C.lane < 33) { const int b = (C.lane - 1) & 15; const double band = 1e-4 + (double)b * ((15.0 - 1e-4) / 15.0);
            double x = (double)pos * band / (double)L; x -= floor(x); float s, c; sincospif((float)(2.0 * x), &s, &c); pe = (C.lane < 17) ? c : -s; }
        const float* w1 = INP(I_HYW1) + l * 33 * 64; const float* w2 = INP(I_HYW2) + l * 64 * 64;
        float a = INP(I_HYB1)[l * 64 + C.lane];
#pragma unroll
        for (int i = 0; i < 33; ++i) a += __shfl(pe, i) * w1[i * 64 + C.lane];
        const float h1 = sinf(a);
        float b = INP(I_HYB2)[l * 64 + C.lane];
#pragma unroll 16
        for (int i = 0; i < 64; ++i) b += __shfl(h1, i) * w2[i * 64 + C.lane];
        H2[(size_t)rw * 64 + C.lane] = sinf(b);
    }
}
__device__ __forceinline__ void p0_prologue(const Ctx& C) {
    mod_gemv(C);
    __syncthreads();
    convert_weights(C, 0);
    h2_rows(C);
    const int gt = C.vcu * NWAVES * 64 + C.tid, NGT = C.G * NWAVES * 64;
    float* PE = (float*)(WSP + WS_PE);
    for (int i = gt; i < 64 * 512; i += NGT) { const int p = i >> 9, j = i & 511, jj = j & 255; const float om = expf(-(float)jj * (9.210340371976184f / 256.f)); const float ang = (float)p * om; PE[i] = (j < 256) ? sinf(ang) : cosf(ang); }
    bf16* RGW = (bf16*)(WSP + WS_RGW);
    for (int i = gt; i < 2 * 2 * 2 * 4 * 4096; i += NGT) {
        const int i_ = i & 63, j = (i >> 6) & 63, hb = (i >> 12) & 3, gate = (i >> 14) & 1, d = (i >> 15) & 1, l = i >> 16;
        const float* src = INP(gate ? I_RGWX : I_RGWA) + ((((size_t)l * 2 + d) * 4 + hb) * 64 + i_) * 64 + j;
        RGW[i] = (bf16)f2bf(*src); }
}
__device__ __forceinline__ int cond_row(int m) { return m < MCTX ? 0 : 1 + ((m - MCTX) >> 12); }
template <bool INIT>
__device__ __forceinline__ void norm_rows(const Ctx& C, const float* gamma, const float* modl, int off_sh, int off_sc) {
    const int gw = C.vcu * NWAVES + C.wave, NGW = C.G * NWAVES;
    float* X = OUTP; bf16* XN = (bf16*)(WSP + WS_XN); const float* PE = (const float*)(WSP + WS_PE);
    for (int m = gw; m < M; m += NGW) {
        const int r = cond_row(m); const float* md = modl + r * 6144;
        f32x4 v[4]; float ss = 0.f;
#pragma unroll
        for (int j = 0; j < 4; ++j) { const int col = 256 * j + 4 * C.lane;
            if (INIT) { if (m < MCTX) v[j] = *(const f32x4*)(INP(I_XP) + (size_t)m * D + col);
                else { const int t = (m - MCTX) & 4095; const int p = (j < 2) ? (t >> 6) : (t & 63);
                    v[j] = *(const f32x4*)(INP(I_XS) + (size_t)(m - MCTX) * D + col) + *(const f32x4*)(PE + p * 512 + (col & 511)); }
                *(f32x4*)(X + (size_t)m * D + col) = v[j]; }
            else v[j] = *(const f32x4*)(X + (size_t)m * D + col);
            ss += (v[j].x * v[j].x + v[j].y * v[j].y) + (v[j].z * v[j].z + v[j].w * v[j].w); }
        const float rstd = 1.f / sqrtf(wave_sum(ss) * (1.f / D) + EPS);
#pragma unroll
        for (int j = 0; j < 4; ++j) { const int col = 256 * j + 4 * C.lane;
            const f32x4 g = *(const f32x4*)(gamma + col), sc = *(const f32x4*)(md + off_sc + col), sh = *(const f32x4*)(md + off_sh + col);
            const f32x4 u = (v[j] * rstd) * g * (sc + 1.f) + sh;
            v2u o; o.x = pk2(u.x, u.y); o.y = pk2(u.z, u.w);
            *(GAS v2u*)(XN + (size_t)m * D + col) = o; }
    }
}
__device__ __forceinline__ void final_norm(const Ctx& C) {
    const int gw = C.vcu * NWAVES + C.wave, NGW = C.G * NWAVES; float* X = OUTP; const float* gamma = INP(I_FNG);
    for (int m = gw; m < M; m += NGW) {
        f32x4 v[4]; float ss = 0.f;
#pragma unroll
        for (int j = 0; j < 4; ++j) { v[j] = *(const f32x4*)(X + (size_t)m * D + 256 * j + 4 * C.lane); ss += (v[j].x * v[j].x + v[j].y * v[j].y) + (v[j].z * v[j].z + v[j].w * v[j].w); }
        const float rstd = 1.f / sqrtf(wave_sum(ss) * (1.f / D) + EPS);
#pragma unroll
        for (int j = 0; j < 4; ++j) { const int col = 256 * j + 4 * C.lane; *(f32x4*)(X + (size_t)m * D + col) = (v[j] * rstd) * *(const f32x4*)(gamma + col); }
    }
}
__device__ __forceinline__ void hyena_filters(const Ctx& C) {
    LAS float* w3s = (LAS float*)C.lds;
    LAS float* red = w3s + 512;
    const float* H2 = (const float*)(WSP + WS_H2);
    for (int u = C.vcu; u < 256; u += C.G) {
        const int l = u >> 7, stream = (u >> 6) & 1, f0 = (u & 63) * 8; const int L = stream ? 256 : 4096; const int nI = stream ? 1 : 8;
        __syncthreads();
        { const int j = C.tid >> 3, e = C.tid & 7; w3s[C.tid] = INP(I_HYW3)[((size_t)l * 64 + j) * 512 + f0 + e]; }
        __syncthreads();
        float hv[8][8];
#pragma unroll
        for (int i = 0; i < 8; ++i)
#pragma unroll
            for (int e = 0; e < 8; ++e) hv[i][e] = 0.f;
        const bool act = C.tid < L;
        const float* hb = H2 + ((size_t)l * 4352 + (stream ? 4096 : 0)) * 64;
        if (act) {
            for (int j = 0; j < 64; j += 4) {
                f32x4 wv[4][2];
#pragma unroll
                for (int q = 0; q < 4; ++q) { wv[q][0] = *(const LAS f32x4*)(w3s + (j + q) * 8); wv[q][1] = *(const LAS f32x4*)(w3s + (j + q) * 8 + 4); }
#pragma unroll
                for (int i = 0; i < 8; ++i) { if (i < nI) { const f32x4 h = *(const f32x4*)(hb + (size_t)(C.tid + 512 * i) * 64 + j);
#pragma unroll
                    for (int q = 0; q < 4; ++q)
#pragma unroll
                        for (int e = 0; e < 8; ++e) hv[i][e] += h[q] * wv[q][e >> 2][e & 3]; } }
            }
        }
        float sm[8];
#pragma unroll
        for (int e = 0; e < 8; ++e) { const float dec = INP(I_HYDEC)[l * 512 + f0 + e]; float s = 0.f;
#pragma unroll
            for (int i = 0; i < 8; ++i) { if (i < nI && act) { const int t = C.tid + 512 * i; const float dist = fabsf((float)(t - L / 2)) / (float)(L / 2); hv[i][e] *= expf(-dist * dec); s += fabsf(hv[i][e]); } }
            sm[e] = wave_sum(s); }
        if (C.lane == 0) {
#pragma unroll
            for (int e = 0; e < 8; ++e) red[C.wave * 8 + e] = sm[e]; }
        __syncthreads();
        if (act) {
#pragma unroll
            for (int e = 0; e < 8; ++e) { float tot = 0.f;
#pragma unroll
                for (int w8 = 0; w8 < 8; ++w8) tot += red[w8 * 8 + e];
                const float inv = 1.f / tot;
                float* dst = stream ? (float*)(WSP + WS_HTC) + ((size_t)l * 512 + f0 + e) * 256 : (float*)(WSP + WS_HT) + ((size_t)l * 512 + f0 + e) * 4096;
#pragma unroll
                for (int i = 0; i < 8; ++i) if (i < nI) dst[C.tid + 512 * i] = hv[i][e] * inv; }
        }
    }
}
__device__ __forceinline__ float gelu_tanh(float x) { const float u = 0.7978845608028654f * (x + 0.044715f * x * x * x); const float t = 1.f - 2.f / (1.f + __expf(2.f * u)); return 0.5f * x * (1.f + t); }
__device__ __forceinline__ float softplusf_(float z) { return fmaxf(z, 0.f) + log1pf(__expf(-fabsf(z))); }
__device__ __forceinline__ bf16x8 pack_bf16x8(f32x4 a, f32x4 b) {
    v4u w; w.x = pk2(a.x, a.y); w.y = pk2(a.z, a.w); w.z = pk2(b.x, b.y); w.w = pk2(b.z, b.w);
    return __builtin_bit_cast(bf16x8, w);
}
__device__ __forceinline__ void rg_main(const Ctx& C, int l, int u) {
    const int seg = u >> 2, hb = u & 3; const bool lat = seg >= 32; const int m0 = seg * 256;
    const int sbeg = lat ? MCTX + ((seg - 32) >> 4) * 4096 : m0, send = lat ? sbeg + 4096 : m0 + 256;
    LAS float* xc = (LAS float*)C.lds; LAS float* hs = xc + 256 * 68;
    const bf16* PROJ = (const bf16*)(WSP + WS_PROJ);
    {
        const int t = C.tid >> 1, c0 = 32 * (C.tid & 1), chg = 64 * hb + c0;
        float acc[32];
        const float* cb = INP(I_RGCB) + l * 256 + chg;
#pragma unroll
        for (int e = 0; e < 32; e += 4) { const f32x4 b = *(const f32x4*)(cb + e); acc[e] = b.x; acc[e + 1] = b.y; acc[e + 2] = b.z; acc[e + 3] = b.w; }
#pragma unroll
        for (int j = 0; j < 4; ++j) { const int mr = m0 + t - 2 + j;
            if (mr >= sbeg && mr < send) { const v4u* xp = (const v4u*)(PROJ + (size_t)mr * pg8::PROJ_LD + 1024 + chg); const float* wp = INP(I_RGCW) + (l * 4 + j) * 256 + chg;
#pragma unroll
                for (int q = 0; q < 4; ++q) { const v4u xv = xp[q]; const f32x4 w0 = *(const f32x4*)(wp + 8 * q), w1 = *(const f32x4*)(wp + 8 * q + 4);
                    acc[8 * q + 0] += w0.x * bflo(xv.x); acc[8 * q + 1] += w0.y * bfhi(xv.x); acc[8 * q + 2] += w0.z * bflo(xv.y); acc[8 * q + 3] += w0.w * bfhi(xv.y);
                    acc[8 * q + 4] += w1.x * bflo(xv.z); acc[8 * q + 5] += w1.y * bfhi(xv.z); acc[8 * q + 6] += w1.z * bflo(xv.w); acc[8 * q + 7] += w1.w * bfhi(xv.w); } } }
#pragma unroll
        for (int e = 0; e < 32; e += 4) { *(LAS f32x4*)(xc + t * 68 + c0 + e) = (f32x4){acc[e], acc[e + 1], acc[e + 2], acc[e + 3]}; *(LAS f32x4*)(hs + t * 68 + c0 + e) = (f32x4){0.f, 0.f, 0.f, 0.f}; }
    }
    __syncthreads();
    {
        const int dir = C.wave >> 2, nt = C.wave & 3, cl = C.lane & 15, g = C.lane >> 4, ch = 16 * nt + cl, chg = 64 * hb + ch;
        const bf16* wb = (const bf16*)(WSP + WS_RGW) + ((size_t)(((l * 2 + dir) * 2 + 0) * 4 + hb) * 64 + ch) * 64 + 8 * g;
        const bf16x8 Ba0 = *(const bf16x8*)(wb), Ba1 = *(const bf16x8*)(wb + 32), Bx0 = *(const bf16x8*)(wb + 16384), Bx1 = *(const bf16x8*)(wb + 16384 + 32);
        const float ba = INP(I_RGBA)[(l * 2 + dir) * 256 + chg], bx = INP(I_RGBX)[(l * 2 + dir) * 256 + chg];
        const float c1 = -8.f * softplusf_(-INP(I_RGLAM)[(l * 2 + dir) * 256 + chg]);
        bf16* RGP = (bf16*)(WSP + WS_RGP) + (size_t)dir * 8192 * 256;
        float carry = 0.f, pc = 1.f;
#pragma unroll 1
        for (int it = 0; it < 16; ++it) {
            const int t0 = 16 * (dir ? 15 - it : it);
            const LAS float* xr = xc + (t0 + cl) * 68 + 8 * g;
            const bf16x8 A0 = pack_bf16x8(*(const LAS f32x4*)(xr), *(const LAS f32x4*)(xr + 4)), A1 = pack_bf16x8(*(const LAS f32x4*)(xr + 32), *(const LAS f32x4*)(xr + 36));
            f32x4 ar = (f32x4){0.f, 0.f, 0.f, 0.f}, ax = ar;
            ar = __builtin_amdgcn_mfma_f32_16x16x32_bf16(A0, Ba0, ar, 0, 0, 0); ar = __builtin_amdgcn_mfma_f32_16x16x32_bf16(A1, Ba1, ar, 0, 0, 0);
            ax = __builtin_amdgcn_mfma_f32_16x16x32_bf16(A0, Bx0, ax, 0, 0, 0); ax = __builtin_amdgcn_mfma_f32_16x16x32_bf16(A1, Bx1, ax, 0, 0, 0);
            float a[4], uu[4];
#pragma unroll
            for (int r = 0; r < 4; ++r) { const float xv = xc[(t0 + 4 * g + r) * 68 + ch]; const float rr = sigmoidf_(ar[r] + ba), ii = sigmoidf_(ax[r] + bx);
                const float la = c1 * rr; a[r] = __expf(la); uu[r] = sqrtf(-expm1f(2.f * la)) * ii * xv; }
            const float Aloc = (a[0] * a[1]) * (a[2] * a[3]);
            const float Uloc = dir ? ((uu[3] * a[2] + uu[2]) * a[1] + uu[1]) * a[0] + uu[0] : ((uu[0] * a[1] + uu[1]) * a[2] + uu[2]) * a[3] + uu[3];
            float hin = carry, pin = pc;
            if (!dir) {
#pragma unroll
                for (int gp = 0; gp < 3; ++gp) { const float Ag = __shfl(Aloc, cl + 16 * gp), Ug = __shfl(Uloc, cl + 16 * gp); if (gp < g) { hin = Ag * hin + Ug; pin *= Ag; } }
            } else {
#pragma unroll
                for (int gp = 3; gp > 0; --gp) { const float Ag = __shfl(Aloc, cl + 16 * gp), Ug = __shfl(Uloc, cl + 16 * gp); if (gp > g) { hin = Ag * hin + Ug; pin *= Ag; } }
            }
            float h[4], p[4];
            if (!dir) { h[0] = a[0] * hin + uu[0]; h[1] = a[1] * h[0] + uu[1]; h[2] = a[2] * h[1] + uu[2]; h[3] = a[3] * h[2] + uu[3];
                        p[0] = pin * a[0]; p[1] = p[0] * a[1]; p[2] = p[1] * a[2]; p[3] = p[2] * a[3];
                        carry = __shfl(h[3], 48 + cl); pc = __shfl(p[3], 48 + cl); }
            else      { h[3] = a[3] * hin + uu[3]; h[2] = a[2] * h[3] + uu[2]; h[1] = a[1] * h[2] + uu[1]; h[0] = a[0] * h[1] + uu[0];
                        p[3] = pin * a[3]; p[2] = p[3] * a[2]; p[1] = p[2] * a[1]; p[0] = p[1] * a[0];
                        carry = __shfl(h[0], cl); pc = __shfl(p[0], cl); }
#pragma unroll
            for (int r = 0; r < 4; ++r) { const int t = t0 + 4 * g + r;
                (void)__hip_atomic_fetch_add(hs + t * 68 + ch, h[r], __ATOMIC_RELAXED, __HIP_MEMORY_SCOPE_WORKGROUP);
                if (lat) RGP[(size_t)(m0 - MCTX + t) * 256 + chg] = (bf16)f2bf(p[r]); }
        }
        if (g == 0) {
            if (lat) { float* ag = (float*)(WSP + WS_RGAGG) + ((size_t)((seg - 32) * 2 + dir) * 256 + chg) * 2; ag[0] = pc; ag[1] = carry; }
            else OUTP[OUT_SRG + ((size_t)(seg * 2 + l) * 2 + dir) * 256 + chg] = carry;
        }
    }
    __syncthreads();
    {
        const int t = C.tid >> 1, c0 = 32 * (C.tid & 1), chg = 64 * hb + c0, m = m0 + t;
        if (!lat) {
            const v4u* gp = (const v4u*)(PROJ + (size_t)m * pg8::PROJ_LD + 1280 + chg); bf16* yp = (bf16*)(WSP + WS_XN) + (size_t)m * 1024 + 256 + chg;
#pragma unroll
            for (int q = 0; q < 4; ++q) { const v4u gv = gp[q]; const f32x4 h0 = *(const LAS f32x4*)(hs + t * 68 + c0 + 8 * q), h1 = *(const LAS f32x4*)(hs + t * 68 + c0 + 8 * q + 4);
                v4u o; o.x = pk2(h0.x * gelu_tanh(bflo(gv.x)), h0.y * gelu_tanh(bfhi(gv.x))); o.y = pk2(h0.z * gelu_tanh(bflo(gv.y)), h0.w * gelu_tanh(bfhi(gv.y)));
                o.z = pk2(h1.x * gelu_tanh(bflo(gv.z)), h1.y * gelu_tanh(bfhi(gv.z))); o.w = pk2(h1.z * gelu_tanh(bflo(gv.w)), h1.w * gelu_tanh(bfhi(gv.w)));
                *(GAS v4u*)(yp + 8 * q) = o; }
        } else {
            float* hp = (float*)(WSP + WS_RGH) + (size_t)(m - MCTX) * 256 + chg;
#pragma unroll
            for (int q = 0; q < 8; ++q) *(f32x4*)(hp + 4 * q) = *(const LAS f32x4*)(hs + t * 68 + c0 + 4 * q);
        }
    }
    __syncthreads();
}
__device__ __forceinline__ void rg_corr(const Ctx& C, int l, int u) {
    const int segl = u >> 2, cg = u & 3, b = segl >> 4, j = segl & 15;
    LAS float* hin = (LAS float*)C.lds;
    __syncthreads();
    if (C.tid < 128) { const int dir = C.tid >> 6, c = C.tid & 63, chg = 64 * cg + c;
        float h = INP(I_SRG)[((size_t)(b * 2 + l) * 2 + dir) * 256 + chg];
        const float* ag = (const float*)(WSP + WS_RGAGG);
        if (dir == 0) { for (int i = 0; i < j; ++i) { const float* a2 = ag + ((size_t)((b * 16 + i) * 2 + 0) * 256 + chg) * 2; h = a2[0] * h + a2[1]; } }
        else { for (int i = 15; i > j; --i) { const float* a2 = ag + ((size_t)((b * 16 + i) * 2 + 1) * 256 + chg) * 2; h = a2[0] * h + a2[1]; } }
        hin[dir * 64 + c] = h; }
    __syncthreads();
    const int t = C.tid >> 1, c0 = 32 * (C.tid & 1), chg = 64 * cg + c0, tl = segl * 256 + t, m = MCTX + tl;
    const bf16* PROJ = (const bf16*)(WSP + WS_PROJ);
    const v4u* gp = (const v4u*)(PROJ + (size_t)m * pg8::PROJ_LD + 1280 + chg); bf16* yp = (bf16*)(WSP + WS_XN) + (size_t)m * 1024 + 256 + chg;
    const float* hp = (const float*)(WSP + WS_RGH) + (size_t)tl * 256 + chg;
    const v4u* pf = (const v4u*)((const bf16*)(WSP + WS_RGP) + (size_t)tl * 256 + chg); const v4u* pb = (const v4u*)((const bf16*)(WSP + WS_RGP) + (size_t)(8192 + tl) * 256 + chg);
#pragma unroll
    for (int q = 0; q < 4; ++q) { const v4u gv = gp[q], fv = pf[q], bv = pb[q]; const f32x4 h0 = *(const f32x4*)(hp + 8 * q), h1 = *(const f32x4*)(hp + 8 * q + 4);
        const LAS float* hf = hin + c0 + 8 * q; const LAS float* hbk = hin + 64 + c0 + 8 * q;
        float hv[8];
        hv[0] = h0.x + bflo(fv.x) * hf[0] + bflo(bv.x) * hbk[0]; hv[1] = h0.y + bfhi(fv.x) * hf[1] + bfhi(bv.x) * hbk[1];
        hv[2] = h0.z + bflo(fv.y) * hf[2] + bflo(bv.y) * hbk[2]; hv[3] = h0.w + bfhi(fv.y) * hf[3] + bfhi(bv.y) * hbk[3];
        hv[4] = h1.x + bflo(fv.z) * hf[4] + bflo(bv.z) * hbk[4]; hv[5] = h1.y + bfhi(fv.z) * hf[5] + bfhi(bv.z) * hbk[5];
        hv[6] = h1.z + bflo(fv.w) * hf[6] + bflo(bv.w) * hbk[6]; hv[7] = h1.w + bfhi(fv.w) * hf[7] + bfhi(bv.w) * hbk[7];
        v4u o; o.x = pk2(hv[0] * gelu_tanh(bflo(gv.x)), hv[1] * gelu_tanh(bfhi(gv.x))); o.y = pk2(hv[2] * gelu_tanh(bflo(gv.y)), hv[3] * gelu_tanh(bfhi(gv.y)));
        o.z = pk2(hv[4] * gelu_tanh(bflo(gv.z)), hv[5] * gelu_tanh(bfhi(gv.z))); o.w = pk2(hv[6] * gelu_tanh(bflo(gv.w)), hv[7] * gelu_tanh(bfhi(gv.w)));
        *(GAS v4u*)(yp + 8 * q) = o; }
}
template <bool MAIN>
__device__ __forceinline__ void gla_unit(const Ctx& C, int l, int seg, int mixer, int hp) {
    const int hd = C.wave >> 1, vh = C.wave & 1, head = 2 * hp + (hd >> 1), dir = hd & 1;
    const int lane = C.lane, vi = lane & 31, kh = lane >> 5, v = 32 * vh + vi;
    LAS float* opnd = (LAS float*)C.lds + hd * (16 * 192);
    LAS float* dpart = (LAS float*)C.lds + 4 * 16 * 192;
    const bool lat = seg >= 32; const int m0 = seg * 256, kch = 64 * head + lane;
    const bf16* PROJ = (const bf16*)(WSP + WS_PROJ);
    float wg[16]; float bg = 0.f, lb = 0.f;
    if (mixer == 0) {
#pragma unroll
        for (int j = 0; j < 16; ++j) wg[j] = INP(I_GLAWG)[((size_t)(l * 2 + dir) * 16 + j) * 256 + kch];
        bg = INP(I_GLABG)[(l * 2 + dir) * 256 + kch];
    } else {
#pragma unroll
        for (int j = 0; j < 16; ++j) wg[j] = 0.f;
        if (l > 0) lb = sigmoidf_(INP(I_HGLOW)[256 + kch] - INP(I_HGLOW)[kch]);
    }
    float S[32];
#pragma unroll
    for (int j = 0; j < 32; ++j) S[j] = 0.f;
    if (MAIN && lat) {
        const int segl = seg - 32, b = segl >> 4, jseg = segl & 15;
        const float* st = INP(mixer ? I_SHG : I_SGLA) + ((size_t)(((b * 2 + l) * 2 + dir) * 4 + head) * 64) * 64;
#pragma unroll
        for (int j = 0; j < 32; ++j) S[j] = st[(32 * kh + j) * 64 + v];
        const float* GS = (const float*)(WSP + WS_GS); const float* GD = (const float*)(WSP + WS_GD);
        const int i0 = dir ? 15 : 0, i1 = jseg, di = dir ? -1 : 1;
#pragma unroll 1
        for (int i = i0; i != i1; i += di) { const size_t ub = (size_t)((((b * 16 + i) * 2 + mixer) * 4 + head) * 2 + dir) * 64;
#pragma unroll
            for (int j = 0; j < 32; ++j) S[j] = GD[ub + 32 * kh + j] * S[j] + GS[(ub + 32 * kh + j) * 64 + v]; }
    }
    float dprod = 1.f;
    const int vcol = (mixer ? 2304 : 512) + 64 * head + v;
    float* OS = (float*)(WSP + WS_OSUM) + 256 * mixer + 64 * head + v;
    __syncthreads();
#pragma unroll 1
    for (int it = 0; it < 16; ++it) {
        float vt[16];
#pragma unroll
        for (int tt = 0; tt < 16; ++tt) { const int ts = dir ? 255 - (16 * it + tt) : 16 * it + tt; vt[tt] = bf2f(PROJ[(size_t)(m0 + ts) * pg8::PROJ_LD + vcol]); }
#pragma unroll
        for (int q = 0; q < 8; ++q) { const int tt = 8 * vh + q; const int ts = dir ? 255 - (16 * it + tt) : 16 * it + tt; const bf16* row = PROJ + (size_t)(m0 + ts) * pg8::PROJ_LD;
            float a, kk, qq;
            if (mixer == 0) { const v4u l0 = *(const v4u*)(row + 2816), l1 = *(const v4u*)(row + 2824);
                float x = bg + wg[0] * bflo(l0.x) + wg[1] * bfhi(l0.x) + wg[2] * bflo(l0.y) + wg[3] * bfhi(l0.y) + wg[4] * bflo(l0.z) + wg[5] * bfhi(l0.z) + wg[6] * bflo(l0.w) + wg[7] * bfhi(l0.w);
                x += wg[8] * bflo(l1.x) + wg[9] * bfhi(l1.x) + wg[10] * bflo(l1.y) + wg[11] * bfhi(l1.y) + wg[12] * bflo(l1.z) + wg[13] * bfhi(l1.z) + wg[14] * bflo(l1.w) + wg[15] * bfhi(l1.w);
                a = __expf(-softplusf_(-x) * 0.0625f); kk = bf2f(row[256 + kch]); qq = bf2f(row[kch]) * 0.125f; }
            else { const float fl = bf2f(row[(dir ? 2048 : 1792) + kch]); const float sg = 1.f / (1.f + __expf(-fl)), sn = 1.f / (1.f + __expf(fl));
                a = lb + (1.f - lb) * sg; kk = (1.f - lb) * sn; const float dq = bf2f(row[1536 + kch]); qq = dq * sigmoidf_(dq); }
            opnd[(tt * 3 + 0) * 64 + lane] = a; opnd[(tt * 3 + 1) * 64 + lane] = kk; opnd[(tt * 3 + 2) * 64 + lane] = qq; dprod *= a; }
        __syncthreads();
#pragma unroll 2
        for (int tt = 0; tt < 16; ++tt) {
            const LAS float* pa = opnd + (tt * 3) * 64 + 32 * kh; const float vv = vt[tt]; float o = 0.f;
#pragma unroll
            for (int j = 0; j < 32; j += 4) { const f32x4 av = *(const LAS f32x4*)(pa + j), kv = *(const LAS f32x4*)(pa + 64 + j);
                S[j] = av.x * S[j] + kv.x * vv; S[j + 1] = av.y * S[j + 1] + kv.y * vv; S[j + 2] = av.z * S[j + 2] + kv.z * vv; S[j + 3] = av.w * S[j + 3] + kv.w * vv;
                if (MAIN) { const f32x4 qv = *(const LAS f32x4*)(pa + 128 + j); o += qv.x * S[j] + qv.y * S[j + 1] + qv.z * S[j + 2] + qv.w * S[j + 3]; } }
            if (MAIN) { o += __shfl_xor(o, 32); const int ts = dir ? 255 - (16 * it + tt) : 16 * it + tt;
                if (kh == 0) atomicAdd(OS + (size_t)(m0 + ts) * 512, o); }
        }
        __syncthreads();
    }
    if (MAIN) {
        if (!lat) { float* so = OUTP + (mixer ? OUT_SHG : OUT_SGLA) + ((size_t)(((seg * 2 + l) * 2 + dir) * 4 + head) * 64) * 64;
#pragma unroll
            for (int j = 0; j < 32; ++j) so[(32 * kh + j) * 64 + v] = S[j]; }
        VM_WAIT(); __syncthreads();
        const int t = C.tid >> 1, hh = 2 * hp + (C.tid & 1), m = m0 + t;
        const float* op = (const float*)(WSP + WS_OSUM) + (size_t)m * 512 + 256 * mixer + 64 * hh;
        f32x4 ov[16]; float ss = 0.f;
#pragma unroll
        for (int q = 0; q < 16; ++q) { ov[q] = *(const f32x4*)(op + 4 * q); ss += (ov[q].x * ov[q].x + ov[q].y * ov[q].y) + (ov[q].z * ov[q].z + ov[q].w * ov[q].w); }
        const float rstd = 1.f / sqrtf(ss * (1.f / 64.f) + EPS);
        const float* gn = INP(mixer ? I_HGNG : I_GLANG) + l * 256 + 64 * hh;
        const v4u* gp = (const v4u*)(PROJ + (size_t)m * pg8::PROJ_LD + (mixer ? 2560 : 768) + 64 * hh);
        bf16* yp = (bf16*)(WSP + WS_XN) + (size_t)m * 1024 + (mixer ? 768 : 0) + 64 * hh;
#pragma unroll
        for (int q = 0; q < 8; ++q) { const v4u gv = gp[q]; const f32x4 g0 = *(const f32x4*)(gn + 8 * q), g1 = *(const f32x4*)(gn + 8 * q + 4); const f32x4 o0 = ov[2 * q] * rstd * g0, o1 = ov[2 * q + 1] * rstd * g1;
            const float z0 = bflo(gv.x), z1 = bfhi(gv.x), z2 = bflo(gv.y), z3 = bfhi(gv.y), z4 = bflo(gv.z), z5 = bfhi(gv.z), z6 = bflo(gv.w), z7 = bfhi(gv.w);
            v4u w; w.x = pk2(o0.x * z0 * sigmoidf_(z0), o0.y * z1 * sigmoidf_(z1)); w.y = pk2(o0.z * z2 * sigmoidf_(z2), o0.w * z3 * sigmoidf_(z3));
            w.z = pk2(o1.x * z4 * sigmoidf_(z4), o1.y * z5 * sigmoidf_(z5)); w.w = pk2(o1.z * z6 * sigmoidf_(z6), o1.w * z7 * sigmoidf_(z7));
            *(GAS v4u*)(yp + 8 * q) = w; }
    } else {
        const int segl = seg - 32; const size_t ub = (size_t)(((segl * 2 + mixer) * 4 + head) * 2 + dir) * 64;
        float* GS = (float*)(WSP + WS_GS);
#pragma unroll
        for (int j = 0; j < 32; ++j) GS[(ub + 32 * kh + j) * 64 + v] = S[j];
        dpart[C.wave * 64 + lane] = dprod;
        __syncthreads();
        if (vh == 0) ((float*)(WSP + WS_GD))[ub + lane] = dpart[C.wave * 64 + lane] * dpart[(C.wave + 1) * 64 + lane];
    }
    __syncthreads();
}
__device__ __forceinline__ void fft_twiddles(const Ctx& C) {
    LAS f32x2* tw = (LAS f32x2*)C.lds + 8192;
#pragma unroll
    for (int q = 0; q < 8; ++q) { const int k = C.tid + 512 * q; float s, c; sincospif((float)k * (1.f / 4096.f), &s, &c); tw[k] = (f32x2){c, -s}; }
}
__device__ __forceinline__ void fft_fwd(LAS f32x2* x, const LAS f32x2* tw, int tid, int lg) {
#pragma unroll 1
    for (int s = lg - 1; s >= 0; --s) { const int half = 1 << s;
#pragma unroll
        for (int q = 0; q < 8; ++q) { const int j = tid + 512 * q, pos = j & (half - 1), i0 = ((j >> s) << (s + 1)) + pos, i1 = i0 + half;
            const f32x2 a = x[i0], b = x[i1], w = tw[pos << (12 - s)], d = a - b;
            x[i0] = a + b; x[i1] = (f32x2){d.x * w.x - d.y * w.y, d.x * w.y + d.y * w.x}; }
        __syncthreads(); }
}
__device__ __forceinline__ void fft_inv(LAS f32x2* x, const LAS f32x2* tw, int tid, int lg) {
#pragma unroll 1
    for (int s = 0; s < lg; ++s) { const int half = 1 << s;
#pragma unroll
        for (int q = 0; q < 8; ++q) { const int j = tid + 512 * q, pos = j & (half - 1), i0 = ((j >> s) << (s + 1)) + pos, i1 = i0 + half;
            const f32x2 a = x[i0], c = x[i1], w = tw[pos << (12 - s)]; const f32x2 b = (f32x2){c.x * w.x + c.y * w.y, c.y * w.x - c.x * w.y};
            x[i0] = a + b; x[i1] = a - b; }
        __syncthreads(); }
}
template <int ORDER>
__device__ __forceinline__ void hy_unit(const Ctx& C, int l, int stream, int c) {
    LAS f32x2* x = (LAS f32x2*)C.lds; const LAS f32x2* tw = x + 8192;
    const int tid = C.tid, lg = stream ? 13 : 9, f = ORDER * 256 + c;
    __syncthreads();
    if (stream) { const float* h = (const float*)(WSP + WS_HT) + ((size_t)l * 512 + f) * 4096;
#pragma unroll
        for (int i = 0; i < 8; ++i) { x[tid + 512 * i] = (f32x2){h[tid + 512 * i], 0.f}; x[tid + 512 * (i + 8)] = (f32x2){0.f, 0.f}; } }
    else { const float* h = (const float*)(WSP + WS_HTC) + ((size_t)l * 512 + f) * 256; const float hv = tid < 256 ? h[tid] : 0.f;
#pragma unroll
        for (int i = 0; i < 16; ++i) x[tid + 512 * i] = (f32x2){hv, 0.f}; }
    __syncthreads();
    fft_fwd(x, tw, tid, lg);
    f32x2 H[16];
#pragma unroll
    for (int i = 0; i < 16; ++i) H[i] = x[tid + 512 * i];
    __syncthreads();
    const int zc = c, gc = (ORDER + 1) * 256 + c;
    const float* cw = INP(I_HYCW) + (size_t)l * 3 * 768; const float* cbp = INP(I_HYCB) + (size_t)l * 768;
    const float zw0 = cw[zc], zw1 = cw[768 + zc], zw2 = cw[1536 + zc], zb = cbp[zc];
    const float gw0 = cw[gc], gw1 = cw[768 + gc], gw2 = cw[1536 + gc], gb = cbp[gc];
    const bf16* CTv = (const bf16*)(WSP + WS_CT) + ((size_t)(c * 2 + stream) * 2) * 8192;
    const bf16* CT2 = (const bf16*)(WSP + WS_CT2) + (size_t)c * 16384;
    float* Z1 = (float*)(WSP + WS_CT) + (size_t)c * 16384;
    const int slen = stream ? 4096 : 256;
    const bool tval = stream ? true : (tid < 256);
    float zr[16], zi[16], gr[16], gi[16];
#pragma unroll
    for (int i = 0; i < 16; ++i) {
        const bool valid = stream ? (i < 8) : tval;
        zr[i] = 0.f; zi[i] = 0.f; gr[i] = 0.f; gi[i] = 0.f;
        if (valid) {
            const int pos = stream ? tid + 512 * i : tid;
            const int mre = stream ? MCTX + pos : (2 * i) * 256 + pos, mim = mre + slen;
            const bool hasl = pos > 0, hasr = pos + 1 < slen;
            if (ORDER == 0) {
                const bf16* v0 = CTv + (mre & 8191); const bf16* v1 = CTv + (mim & 8191);
                zr[i] = zb + zw1 * bf2f(v0[0]) + (hasl ? zw0 * bf2f(v0[-1]) : 0.f) + (hasr ? zw2 * bf2f(v0[1]) : 0.f);
                zi[i] = zb + zw1 * bf2f(v1[0]) + (hasl ? zw0 * bf2f(v1[-1]) : 0.f) + (hasr ? zw2 * bf2f(v1[1]) : 0.f);
                const bf16* g0 = v0 + 8192; const bf16* g1 = v1 + 8192;
                gr[i] = gb + gw1 * bf2f(g0[0]) + (hasl ? gw0 * bf2f(g0[-1]) : 0.f) + (hasr ? gw2 * bf2f(g0[1]) : 0.f);
                gi[i] = gb + gw1 * bf2f(g1[0]) + (hasl ? gw0 * bf2f(g1[-1]) : 0.f) + (hasr ? gw2 * bf2f(g1[1]) : 0.f);
            } else {
                zr[i] = Z1[mre]; zi[i] = Z1[mim];
                const bf16* g0 = CT2 + mre; const bf16* g1 = CT2 + mim;
                gr[i] = gb + gw1 * bf2f(g0[0]) + (hasl ? gw0 * bf2f(g0[-1]) : 0.f) + (hasr ? gw2 * bf2f(g0[1]) : 0.f);
                gi[i] = gb + gw1 * bf2f(g1[0]) + (hasl ? gw0 * bf2f(g1[-1]) : 0.f) + (hasr ? gw2 * bf2f(g1[1]) : 0.f);
            }
        }
        x[tid + 512 * i] = (f32x2){zr[i], zi[i]};
    }
    __syncthreads();
    fft_fwd(x, tw, tid, lg);
#pragma unroll
    for (int i = 0; i < 16; ++i) { const f32x2 a = x[tid + 512 * i]; x[tid + 512 * i] = (f32x2){a.x * H[i].x - a.y * H[i].y, a.x * H[i].y + a.y * H[i].x}; }
    __syncthreads();
    fft_inv(x, tw, tid, lg);
    const float skip = INP(I_HYSKIP)[l * 512 + f];
    const float scale = stream ? (1.f / 8192.f) : (1.f / 512.f);
    const int shift = stream ? 2048 : 128;
    int tid2 = tid; asm volatile("" : "+v"(tid2));
    const bool tval2 = stream ? true : (tid2 < 256);
    bf16* Yb = (bf16*)(WSP + WS_XN) + 512 + c;
#pragma unroll
    for (int i = 0; i < 16; ++i) {
        const bool valid = stream ? (i < 8) : tval2;
        if (valid) {
            const int pos = stream ? tid2 + 512 * i : tid2;
            const unsigned mre = stream ? MCTX + pos : (2 * i) * 256 + pos, mim = mre + slen;
            const f32x2 y = x[tid2 + 512 * i + shift];
            const float ore = gr[i] * (y.x * scale + skip * zr[i]), oim = gi[i] * (y.y * scale + skip * zi[i]);
            if (ORDER == 0) { Z1[mre] = ore; Z1[mim] = oim; }
            else { Yb[mre * 1024u] = (bf16)f2bf(ore); Yb[mim * 1024u] = (bf16)f2bf(oim); }
        }
    }
    __syncthreads();
}
__device__ __forceinline__ void mixers_pass1(const Ctx& C, int l) {
    {
        const int gt = C.vcu * NWAVES * 64 + C.tid, NGT = C.G * NWAVES * 64; v4u* Z = (v4u*)(WSP + WS_OSUM);
        for (int i = gt; i < M * 512 / 4; i += NGT) Z[i] = (v4u){0u, 0u, 0u, 0u};
    }
    for (int u = C.vcu; u < 256; u += C.G) rg_main(C, l, u);
    __syncthreads();
    fft_twiddles(C);
    for (int u = C.vcu; u < 256; u += C.G) { hy_unit<0>(C, l, 1, u); hy_unit<0>(C, l, 0, u); }
    for (int u = C.vcu; u < 128; u += C.G) gla_unit<false>(C, l, 32 + (u >> 2), (u >> 1) & 1, u & 1);
}
__device__ __forceinline__ void mixers_pass2(const Ctx& C, int l) {
    for (int u = C.vcu; u < 256; u += C.G) gla_unit<true>(C, l, u >> 2, (u >> 1) & 1, u & 1);
    __syncthreads();
    fft_twiddles(C);
    for (int u = C.vcu; u < 256; u += C.G) { hy_unit<1>(C, l, 1, u); hy_unit<1>(C, l, 0, u); }
    for (int u = C.vcu; u < 128; u += C.G) rg_corr(C, l, u);
}
template <int l>
__device__ __forceinline__ void layer_phases(const Ctx& C, const int lo, const int hi, const XcdBarrier& bar) {
#define IN(k) (lo <= (k) && (k) < hi)
#define SEAM(k) do { if (IN((k) + 1)) xcd_barrier(bar); } while (0)
    float* const modp = (float*)(WSP + WS_MOD);
    bf16* const XN = (bf16*)(WSP + WS_XN); bf16* const PROJ = (bf16*)(WSP + WS_PROJ);
        constexpr int pb = (l == 0) ? 2 : 10;
        const float* modl = modp + (size_t)l * 3 * 6144;
        if (IN(pb + 0)) {
            pg8::Gemm g{XN, (const bf16*)(WSP + WS_WIN), M, NIN, D}; pg8::StaticOrder S; S.init(M, NIN, C.G, (int)blockIdx.x);
            pg8::EpiProj E{PROJ, (bf16*)(WSP + WS_CT), (bf16*)(WSP + WS_CT2)};
            pg8::gemm_phase<pg8::EpiProj, pg8::StaticOrder, true, true>(C.lds, g, S, E);
            SEAM(pb + 0);
        }
        if (IN(pb + 1)) { mixers_pass1(C, l); SEAM(pb + 1); }
        if (IN(pb + 2)) { mixers_pass2(C, l); SEAM(pb + 2); }
        if (IN(pb + 3)) {
            pg8::Gemm g{XN, (const bf16*)(WSP + WS_WOUT), M, D, D}; pg8::StaticOrder S; S.init(M, D, C.G, (int)blockIdx.x);
            pg8::EpiResid E{OUTP, modl + 2048};
            pg8::gemm_phase<pg8::EpiResid, pg8::StaticOrder, true, true>(C.lds, g, S, E);
            SEAM(pb + 3);
        }
        if (IN(pb + 4)) { norm_rows<false>(C, INP(I_N2G) + l * D, modl, 3072, 4096); SEAM(pb + 4); }
        if (IN(pb + 5)) {
            pg8::Gemm g{XN, (const bf16*)(WSP + WS_W13), M, 2 * DFF, D}; pg8::StaticOrder S; S.init(M, 2 * DFF, C.G, (int)blockIdx.x);
            pg8::EpiSwiGLU E{PROJ, DFF};
            pg8::gemm_phase<pg8::EpiSwiGLU, pg8::StaticOrder, true, true>(C.lds, g, S, E);
            SEAM(pb + 5);
        }
        if (IN(pb + 6)) {
            pg8::Gemm g{PROJ, (const bf16*)(WSP + WS_W2), M, D, DFF}; pg8::StaticOrder S; S.init(M, D, C.G, (int)blockIdx.x);
            pg8::EpiResid E{OUTP, modl + 5120};
            pg8::gemm_phase<pg8::EpiResid, pg8::StaticOrder, true, true>(C.lds, g, S, E);
            SEAM(pb + 6);
        }
        if (l == 0 && IN(9)) { convert_weights(C, 1); norm_rows<false>(C, INP(I_N1G) + D, modp + 3 * 6144, 0, 1024); SEAM(9); }
#undef IN
#undef SEAM
}
struct Args { const float* in[N_IN]; float* out; unsigned char* ws; int ph_lo, ph_hi; };
constexpr int N_PHASES = 18;
__global__ void __launch_bounds__(NWAVES * 64, 2) mk_fwd(Args args) {
    extern __shared__ __attribute__((aligned(16))) unsigned char lds_raw[];
    Ctx C;
    C.lds = (LAS unsigned char*)lds_raw;
    C.tid = threadIdx.x; C.lane = C.tid & 63; C.wave = __builtin_amdgcn_readfirstlane(C.tid >> 6);
    C.G = gridDim.x; { const int bx = blockIdx.x; C.vcu = (C.G % 8 == 0) ? (bx % 8) * (C.G / 8) + bx / 8 : bx; }
    volatile LAS unsigned* MISC = (volatile LAS unsigned*)(C.lds + MISC_OFF);
    for (int u = C.tid; u < (LDS_BYTES - LDSCTL_OFF) / 4; u += NWAVES * 64) ((LAS unsigned*)(C.lds + LDSCTL_OFF))[u] = 0u;
    __syncthreads();
    const int lo = args.ph_lo, hi = args.ph_hi;
    const bool use_bar = (hi - lo) > 1;
    XcdBarrier bar; bar.bar = (unsigned*)(WSP + WS_CTL) + CW_BAR; bar.x = 0; bar.st = nullptr;
    if (use_bar) bar = xcd_barrier_post((unsigned*)(WSP + WS_CTL) + CW_BAR, MISC + 8);
#define IN(k) (lo <= (k) && (k) < hi)
#define SEAM(k) do { if (IN((k) + 1)) xcd_barrier(bar); } while (0)
    float* const modp = (float*)(WSP + WS_MOD);
    bf16* const XN = (bf16*)(WSP + WS_XN); bf16* const PROJ = (bf16*)(WSP + WS_PROJ);

    if (IN(0)) { p0_prologue(C); SEAM(0); }
    if (IN(1)) { norm_rows<true>(C, INP(I_N1G), modp, 0, 1024); hyena_filters(C); SEAM(1); }
    layer_phases<0>(C, lo, hi, bar);
    layer_phases<1>(C, lo, hi, bar);
    if (IN(17)) final_norm(C);
#undef IN
#undef SEAM
}

#ifndef MK_N_LAUNCHES
#define MK_N_LAUNCHES 1
#endif
extern "C" void kernel_launch(void* const* d_in, const int* in_sizes, int n_in, void* d_out, int out_size, void* d_ws, size_t ws_size, hipStream_t stream) {
    static int grid = 0;
    if (grid == 0) {
        if (n_in != N_IN || out_size != (int)OUT_END || ws_size < WS_END) { fprintf(stderr, "kernel_launch: unexpected sizes n_in %d out %d ws %zu\n", n_in, out_size, ws_size); grid = -1; return; }
        int dev = 0, cus = 0, per_cu = 0;
        if (hipGetDevice(&dev) != hipSuccess || hipDeviceGetAttribute(&cus, hipDeviceAttributeMultiprocessorCount, dev) != hipSuccess) { grid = -1; return; }
        if (hipFuncSetAttribute((const void*)mk_fwd, hipFuncAttributeMaxDynamicSharedMemorySize, LDS_BYTES) != hipSuccess) { fprintf(stderr, "kernel_launch: hipFuncSetAttribute failed\n"); grid = -1; return; }
        if (hipOccupancyMaxActiveBlocksPerMultiprocessor(&per_cu, (const void*)mk_fwd, NWAVES * 64, LDS_BYTES) != hipSuccess || per_cu < 1) { fprintf(stderr, "kernel_launch: occupancy query says %d blocks per CU\n", per_cu); per_cu = 1; }
        (void)hipGetLastError();
        grid = cus;
    }
    if (grid < 0) return;
    if (hipMemsetAsync((char*)d_ws + WS_CTL, 0, CTL_ZERO_BYTES, stream) != hipSuccess) { fprintf(stderr, "kernel_launch: memset failed\n"); return; }
    Args a{};
    for (int i = 0; i < N_IN; ++i) a.in[i] = (const float*)d_in[i];
    a.out = (float*)d_out; a.ws = (unsigned char*)d_ws;
#if MK_N_LAUNCHES == 1
    a.ph_lo = 0; a.ph_hi = N_PHASES;
    hipLaunchKernelGGL(mk_fwd, dim3(grid), dim3(NWAVES * 64), LDS_BYTES, stream, a);
#else
    for (int p = 0; p < N_PHASES; ++p) { a.ph_lo = p; a.ph_hi = p + 1; hipLaunchKernelGGL(mk_fwd, dim3(grid), dim3(NWAVES * 64), LDS_BYTES, stream, a); }
#endif
    const hipError_t le = hipPeekAtLastError();
    if (le != hipSuccess) fprintf(stderr, "kernel_launch: launch failed: %s\n", hipGetErrorName(le));
}
```

```cpp
#include <hip/hip_runtime.h>
#include <cstdio>
#include <cstdint>
#include <cmath>
namespace pg8 {
#define PG8_LAS __attribute__((address_space(3)))
typedef unsigned short bf16_t;
typedef short bf16x8 __attribute__((ext_vector_type(8)));
typedef float f32x4 __attribute__((ext_vector_type(4)));
typedef unsigned u32x4 __attribute__((ext_vector_type(4)));
constexpr int BM = 256, BK = 64, HALF = 128, HTB = HALF * BK * 2  , STAGE_BYTES = 8 * HTB, NXCD = 8, WGM = 8;

__host__ __device__ __forceinline__ int lds_byte(int r, int c) { const int st = (r >> 4) * 2 + (c >> 5), rr = r & 15, cc = c & 31, ob = rr * 64 + cc * 2; return st * 1024 + (ob ^ (((ob >> 9) & 1) << 5)); }
__host__ __device__ __forceinline__ void stage_rc(int b, int& R, int& C) { const int st = b / 1024, sb = b % 1024, swz = sb ^ (((sb >> 9) & 1) << 5); R = (st >> 1) * 16 + swz / 64; C = (st & 1) * 32 + (swz % 64) / 2; }
__host__ __device__ __forceinline__ int perm32(int rho) { const int n = rho >> 4, i = rho & 15; return 8 * (i >> 2) + 4 * n + (i & 3); }

struct Unit { int pm, pn; };
struct Gemm { const bf16_t* A; const bf16_t* Bt; int M, N, K; };

struct StaticOrder {
    int nM, nN, nwg, G, c;
    __host__ __device__ void init(int M, int N, int G_, int c_) { nM = M / BM; nN = N / BM; nwg = nM * nN; G = G_; c = c_; }
    __host__ __device__ bool next(int i, Unit& u) const {
        const long L = (long)i * G + c; if (L >= nwg) return false;
        int wgid = (int)L; { const int q = nwg / NXCD, r = nwg % NXCD, xcd = wgid % NXCD, off = wgid / NXCD; wgid = (xcd < r ? xcd * (q + 1) : r * (q + 1) + (xcd - r) * q) + off; }
        const int nig = WGM * nN, gid = wgid / nig, fm = gid * WGM, gsz = (nM - fm) < WGM ? (nM - fm) : WGM;
        u.pm = fm + ((wgid % nig) % gsz); u.pn = (wgid % nig) / gsz; return true;
    }
    __device__ __forceinline__ void a_ready(const Unit&) const {}
    __device__ __forceinline__ void done(const Unit&) const {}
};
__device__ __forceinline__ unsigned cvt_pk_bf16(float lo, float hi) { unsigned r; asm volatile("v_cvt_pk_bf16_f32 %0, %1, %2" : "=v"(r) : "v"(lo), "v"(hi)); return r; }
typedef float f32x2 __attribute__((ext_vector_type(2)));
constexpr int PROJ_LD = 2848;
struct EpiProj {
    static constexpr bool PERM = true, AFTER_DRAIN = false;
    bf16_t* PROJ; bf16_t* CT; bf16_t* CT2;
    __device__ __forceinline__ void operator()(const f32x4 (&acc)[2][2][4][2], const Unit& u, int wr, int wc, int fr, int fq) const {
        const int row0 = u.pm * BM + wr * 64 + fr;
        if (u.pn >= 3) {
            const bool lrt = (u.pn == 14);
            if (lrt && !(wc == 0 && fq < 2)) return;
            const unsigned voff0 = (unsigned)row0 * (unsigned)PROJ_LD + (unsigned)((u.pn - 3) * 256 + wc * 32 + 8 * fq);
#pragma unroll
            for (int ai = 0; ai < 2; ++ai)
#pragma unroll
                for (int m = 0; m < 4; ++m) { unsigned voff = voff0 + (unsigned)((ai * HALF + m * 16) * PROJ_LD); asm volatile("" : "+v"(voff));
#pragma unroll
                    for (int bj = 0; bj < 2; ++bj) { if (lrt && bj == 1) continue;
                        const f32x4 v0 = acc[ai][bj][m][0], v1 = acc[ai][bj][m][1];
                        u32x4 w; w.x = cvt_pk_bf16(v0[0], v0[1]); w.y = cvt_pk_bf16(v0[2], v0[3]); w.z = cvt_pk_bf16(v1[0], v1[1]); w.w = cvt_pk_bf16(v1[2], v1[3]);
                        *(u32x4*)(PROJ + voff + bj * HALF) = w; } }
        } else {
            bf16_t* base = (u.pn == 0) ? CT : (u.pn == 1) ? CT + 8192 : CT2;
            const unsigned cs = (u.pn == 2) ? 16384u : 32768u;
            const unsigned rofs = (u.pn == 2) ? (unsigned)row0 : ((unsigned)(row0 & 8191) + ((row0 >> 13) ? 16384u : 0u));
            const unsigned voff0 = (unsigned)(wc * 32 + 8 * fq) * cs + rofs;
#pragma unroll
            for (int bj = 0; bj < 2; ++bj)
#pragma unroll
                for (int n = 0; n < 2; ++n)
#pragma unroll
                    for (int e = 0; e < 4; e += 2) { unsigned voff = voff0 + (unsigned)(bj * HALF + 4 * n + e) * cs; asm volatile("" : "+v"(voff)); unsigned voff1 = voff + cs; asm volatile("" : "+v"(voff1));
#pragma unroll
                        for (int ai = 0; ai < 2; ++ai)
#pragma unroll
                            for (int m = 0; m < 4; ++m) { const unsigned w = cvt_pk_bf16(acc[ai][bj][m][n][e], acc[ai][bj][m][n][e + 1]);
                                base[voff + ai * HALF + m * 16] = (bf16_t)(w & 0xffffu); base[voff1 + ai * HALF + m * 16] = (bf16_t)(w >> 16); }
                        asm volatile("" ::: "memory"); }
        }
    }
};
struct EpiResid {
    static constexpr bool PERM = false, AFTER_DRAIN = false;
    float* X; const float* gate3;
    __device__ __forceinline__ void operator()(const f32x4 (&acc)[2][2][4][2], const Unit& u, int wr, int wc, int fr, int fq) const {
        const int r = (u.pm < 32) ? 0 : 1 + ((u.pm - 32) >> 4);
        const float* g = gate3 + r * 6144;
        const int col0 = u.pn * BM + wc * 32 + 4 * fq;
        f32x4 gv[2][2];
#pragma unroll
        for (int bj = 0; bj < 2; ++bj)
#pragma unroll
            for (int n = 0; n < 2; ++n) gv[bj][n] = *(const f32x4*)(g + col0 + bj * HALF + n * 16);
#pragma unroll
        for (int ai = 0; ai < 2; ++ai)
#pragma unroll
            for (int m = 0; m < 4; ++m) { float* rowp = X + (size_t)(u.pm * BM + ai * HALF + wr * 64 + m * 16 + fr) * 1024 + col0;
#pragma unroll
                for (int bj = 0; bj < 2; ++bj)
#pragma unroll
                    for (int n = 0; n < 2; ++n) { f32x4* p = (f32x4*)(rowp + bj * HALF + n * 16); const f32x4 x = *p; *p = x + gv[bj][n] * acc[ai][bj][m][n]; } }
    }
};
struct EpiSwiGLU {
    static constexpr bool PERM = true, AFTER_DRAIN = false;
    bf16_t* HID; int ldh;
    __device__ __forceinline__ void operator()(const f32x4 (&acc)[2][2][4][2], const Unit& u, int wr, int wc, int fr, int fq) const {
        const int row0 = u.pm * BM + wr * 64 + fr, col0 = u.pn * HALF + wc * 32 + 8 * fq;
#pragma unroll
        for (int ai = 0; ai < 2; ++ai)
#pragma unroll
            for (int m = 0; m < 4; ++m) { float h[8];
#pragma unroll
                for (int n = 0; n < 2; ++n)
#pragma unroll
                    for (int e = 0; e < 4; ++e) { const float a = acc[ai][0][m][n][e], b = acc[ai][1][m][n][e]; h[4 * n + e] = a * b * __builtin_amdgcn_rcpf(1.f + __expf(-a)); }
                u32x4 w; w.x = cvt_pk_bf16(h[0], h[1]); w.y = cvt_pk_bf16(h[2], h[3]); w.z = cvt_pk_bf16(h[4], h[5]); w.w = cvt_pk_bf16(h[6], h[7]);
                *(u32x4*)(HID + (size_t)(row0 + ai * HALF + m * 16) * ldh + col0) = w; }
    }
};
template <class Epi, class Sched, bool ALIGN_EPI = false, bool SP2 = false>
__device__ __forceinline__ void gemm_phase(PG8_LAS unsigned char* lds, const Gemm g, const Sched& S, const Epi& E) {
    const int tid = threadIdx.x, wid = __builtin_amdgcn_readfirstlane(tid >> 6), lane = tid & 63, wr = wid >> 2, wc = wid & 3, fr = lane & 15, fq = lane >> 4;
    const int K = g.K, nt = K / BK;
    unsigned voffA[2], voffB[2];
#pragma unroll
    for (int i = 0; i < 2; ++i) { int R, C; stage_rc(tid * 16 + i * 8192, R, C); const int Rb = Epi::PERM ? ((R & ~31) + perm32(R & 31)) : R;
        voffA[i] = (unsigned)(R * K + C) * 2u; voffB[i] = (unsigned)(Rb * K + C) * 2u; }
    const size_t kstep = (size_t)(BK * 2);
    const size_t hstep = (size_t)HALF * K * 2;
    const size_t tstep = 2 * hstep;
    const unsigned ldsw = (unsigned)wid * 1024u;
    const int aoff = lds_byte(wr * 64 + fr, fq * 8), boff = lds_byte(wc * 32 + fr, fq * 8);
#define PG8_SA(b, h) (((b) * 2 + (h)) * HTB)
#define PG8_SB(b, h) ((4 + (b) * 2 + (h)) * HTB)
#define PG8_STAGE(bufoff, gbase, voff) do { _Pragma("unroll") for (int _i = 0; _i < 2; ++_i) \
        __builtin_amdgcn_global_load_lds((const unsigned*)((const char*)(gbase) + (voff)[_i]), (PG8_LAS unsigned*)(lds + (bufoff) + ldsw + _i * 8192), 16, 0, 0); } while (0)
#define PG8_LDA(dst, b, h) do { _Pragma("unroll") for (int m = 0; m < 4; ++m) _Pragma("unroll") for (int k = 0; k < 2; ++k) dst[m][k] = *(const PG8_LAS bf16x8*)(lds + PG8_SA(b, h) + aoff + m * 2048 + k * 1024); } while (0)
#define PG8_LDB(dst, b, h) do { _Pragma("unroll") for (int n = 0; n < 2; ++n) _Pragma("unroll") for (int k = 0; k < 2; ++k) dst[n][k] = *(const PG8_LAS bf16x8*)(lds + PG8_SB(b, h) + boff + n * 2048 + k * 1024); } while (0)
#define PG8_MMA(ai, bj, At, Bt) do { __builtin_amdgcn_s_setprio(1); _Pragma("unroll") for (int m = 0; m < 4; ++m) _Pragma("unroll") for (int n = 0; n < 2; ++n) _Pragma("unroll") for (int k = 0; k < 2; ++k) \
        acc[ai][bj][m][n] = __builtin_amdgcn_mfma_f32_16x16x32_bf16(Bt[n][k], At[m][k], acc[ai][bj][m][n], 0, 0, 0); __builtin_amdgcn_s_setprio(0); } while (0)
#define PG8_WAIT_V(n) asm volatile("s_waitcnt vmcnt(" #n ")" ::: "memory")
#define PG8_WAIT_L(n) asm volatile("s_waitcnt lgkmcnt(" #n ")" ::: "memory")
#define PG8_BAR __builtin_amdgcn_s_barrier()
#define PG8_SCHED __builtin_amdgcn_sched_barrier(0)
    Unit cur, nxt; int ui = 0;
    if (!S.next(0, cur)) return;
    f32x4 acc[2][2][4][2];
#pragma unroll
    for (int a = 0; a < 2; ++a)
#pragma unroll
        for (int b = 0; b < 2; ++b)
#pragma unroll
            for (int m = 0; m < 4; ++m)
#pragma unroll
                for (int n = 0; n < 2; ++n) acc[a][b][m][n] = (f32x4){0.f, 0.f, 0.f, 0.f};
    bf16x8 At[4][2], B0[2][2], B1[2][2];
    const char* cA = (const char*)g.A + (size_t)cur.pm * tstep; const char* cB = (const char*)g.Bt + (size_t)cur.pn * tstep;
    S.a_ready(cur);
    if constexpr (SP2) {
        PG8_STAGE(PG8_SB(0, 0), cB, voffB); PG8_STAGE(PG8_SB(0, 1), cB + hstep, voffB); PG8_STAGE(PG8_SA(0, 0), cA, voffA); PG8_STAGE(PG8_SA(0, 1), cA + hstep, voffA);
        if (wr == 1) PG8_BAR;
        PG8_WAIT_V(2); PG8_BAR;
        PG8_STAGE(PG8_SB(1, 0), cB + kstep, voffB); PG8_STAGE(PG8_SA(1, 0), cA + kstep, voffA); PG8_STAGE(PG8_SB(1, 1), cB + hstep + kstep, voffB);
        PG8_WAIT_V(6); PG8_BAR;
    } else {
        PG8_STAGE(PG8_SB(0, 0), cB, voffB); PG8_STAGE(PG8_SA(0, 0), cA, voffA); PG8_STAGE(PG8_SB(0, 1), cB + hstep, voffB); PG8_STAGE(PG8_SA(0, 1), cA + hstep, voffA);
        if (wr == 1) PG8_BAR;
        PG8_WAIT_V(4); PG8_BAR;
        PG8_STAGE(PG8_SB(1, 0), cB + kstep, voffB); PG8_STAGE(PG8_SA(1, 0), cA + kstep, voffA); PG8_STAGE(PG8_SB(1, 1), cB + hstep + kstep, voffB);
        PG8_WAIT_V(6); PG8_BAR;
    }
    for (;;) {
        const bool has_next = S.next(ui + 1, nxt);
        const char* nA = has_next ? (const char*)g.A + (size_t)nxt.pm * tstep : cA; const char* nB = has_next ? (const char*)g.Bt + (size_t)nxt.pn * tstep : cB;
        for (int t = 0; t < nt; t += 2) {
            const bool last = (t == nt - 2);
            const char* a1 = cA + (size_t)(t + 1) * kstep;
            const char* a2 = last ? nA : cA + (size_t)(t + 2) * kstep; const char* b2 = last ? nB : cB + (size_t)(t + 2) * kstep;
            const char* a3 = a2 + kstep; const char* b3 = b2 + kstep;
            if (last && has_next) S.a_ready(nxt);
            if constexpr (SP2) {
            PG8_LDB(B0, 0, 0); PG8_LDB(B1, 0, 1); PG8_SCHED; PG8_LDA(At, 0, 0); PG8_STAGE(PG8_SA(1, 1), a1 + hstep, voffA);
            PG8_WAIT_V(8); PG8_WAIT_L(0); PG8_BAR; PG8_MMA(0, 0, At, B0); PG8_MMA(0, 1, At, B1); PG8_BAR; PG8_SCHED;
            PG8_LDA(At, 0, 1); PG8_STAGE(PG8_SB(0, 0), b2, voffB); PG8_STAGE(PG8_SB(0, 1), b2 + hstep, voffB); PG8_STAGE(PG8_SA(0, 0), a2, voffA);
            PG8_WAIT_V(8); PG8_WAIT_L(0); PG8_BAR; PG8_MMA(1, 0, At, B0); PG8_MMA(1, 1, At, B1); PG8_BAR; PG8_SCHED;
            PG8_LDB(B0, 1, 0); PG8_LDB(B1, 1, 1); PG8_SCHED; PG8_LDA(At, 1, 0); PG8_STAGE(PG8_SA(0, 1), a2 + hstep, voffA);
            PG8_WAIT_V(8); PG8_WAIT_L(0); PG8_BAR; PG8_MMA(0, 0, At, B0); PG8_MMA(0, 1, At, B1); PG8_BAR; PG8_SCHED;
            PG8_LDA(At, 1, 1); PG8_STAGE(PG8_SB(1, 0), b3, voffB); PG8_STAGE(PG8_SB(1, 1), b3 + hstep, voffB); PG8_STAGE(PG8_SA(1, 0), a3, voffA);
            PG8_WAIT_V(8); PG8_WAIT_L(0); PG8_BAR; PG8_MMA(1, 0, At, B0); PG8_MMA(1, 1, At, B1); PG8_BAR; PG8_SCHED;
            } else {
            PG8_LDB(B0, 0, 0); PG8_SCHED; PG8_LDA(At, 0, 0); PG8_STAGE(PG8_SA(1, 1), a1 + hstep, voffA);
            PG8_WAIT_L(8); PG8_BAR; PG8_WAIT_L(0); PG8_MMA(0, 0, At, B0); PG8_BAR; PG8_SCHED;
            PG8_LDB(B1, 0, 1); PG8_STAGE(PG8_SB(0, 0), b2, voffB);
            PG8_BAR; PG8_WAIT_L(0); PG8_MMA(0, 1, At, B1); PG8_BAR;
            PG8_LDA(At, 0, 1); PG8_STAGE(PG8_SA(0, 0), a2, voffA);
            PG8_BAR; PG8_WAIT_L(0); PG8_MMA(1, 0, At, B0); PG8_BAR; PG8_SCHED;
            PG8_STAGE(PG8_SB(0, 1), b2 + hstep, voffB);
            PG8_WAIT_V(6); PG8_BAR; PG8_MMA(1, 1, At, B1); PG8_BAR;
            PG8_LDB(B0, 1, 0); PG8_SCHED; PG8_LDA(At, 1, 0); PG8_STAGE(PG8_SA(0, 1), a2 + hstep, voffA);
            PG8_WAIT_L(8); PG8_BAR; PG8_WAIT_L(0); PG8_MMA(0, 0, At, B0); PG8_BAR; PG8_SCHED;
            PG8_LDB(B1, 1, 1); PG8_STAGE(PG8_SB(1, 0), b3, voffB);
            PG8_BAR; PG8_WAIT_L(0); PG8_MMA(0, 1, At, B1); PG8_BAR;
            PG8_LDA(At, 1, 1); PG8_STAGE(PG8_SA(1, 0), a3, voffA);
            PG8_BAR; PG8_WAIT_L(0); PG8_MMA(1, 0, At, B0); PG8_BAR; PG8_SCHED;
            PG8_STAGE(PG8_SB(1, 1), b3 + hstep, voffB);
            PG8_WAIT_V(6); PG8_BAR; PG8_MMA(1, 1, At, B1); PG8_BAR;
            }
        }
        if constexpr (ALIGN_EPI) { if (wr == 0) PG8_BAR; }
        if constexpr (!Epi::AFTER_DRAIN) { E(acc, cur, wr, wc, fr, fq); S.done(cur); }
        if (!has_next) break;
#pragma unroll
        for (int a = 0; a < 2; ++a)
#pragma unroll
            for (int b = 0; b < 2; ++b)
#pragma unroll
                for (int m = 0; m < 4; ++m)
#pragma unroll
                    for (int n = 0; n < 2; ++n) acc[a][b][m][n] = (f32x4){0.f, 0.f, 0.f, 0.f};
        cur = nxt; cA = nA; cB = nB; ++ui;
        if constexpr (ALIGN_EPI) { if (wr == 1) PG8_BAR; }
    }
    PG8_WAIT_V(0);
    if constexpr (!ALIGN_EPI) { if (wr == 0) PG8_BAR; }
    PG8_BAR;
    if constexpr (Epi::AFTER_DRAIN) { E.fused(acc, cur, wr, wc, fr, fq, lds, wid, lane); S.done(cur); }
#undef PG8_SA
#undef PG8_SB
#undef PG8_STAGE
#undef PG8_LDA
#undef PG8_LDB
#undef PG8_MMA
#undef PG8_WAIT_V
#undef PG8_WAIT_L
#undef PG8_BAR
#undef PG8_SCHED
}
}
#ifndef REP_RG
#define REP_RG 1
#endif
#ifndef REP_AGG
#define REP_AGG 1
#endif
#ifndef REP_HY
#define REP_HY 1
#endif
#ifndef REP_GIN
#define REP_GIN 1
#endif
#ifndef REP_GUP
#define REP_GUP 1
#endif
#ifndef REP_NORM
#define REP_NORM 1
#endif
#ifndef REP_P0
#define REP_P0 1
#endif
#ifndef REP_P1
#define REP_P1 1
#endif
constexpr int NWAVES = 8;
constexpr int D = 1024, M = 16384, MCTX = 8192, DFF = 2816, NIN = 3840, DIN = 3600;
constexpr float EPS = 1e-6f;
constexpr size_t MiB = 1u << 20;
constexpr size_t WS_CTL = 0, CTL_ZERO_BYTES = MiB;
constexpr size_t WS_MOD = 512 * 1024;
constexpr size_t WS_SMALL = 1 * MiB;
constexpr size_t WS_PE = WS_SMALL + 147456;
constexpr size_t WS_RGW = WS_PE + 131072;
constexpr size_t WS_RGAGG = WS_RGW + 262144;
constexpr size_t WS_GD = WS_RGAGG + 131072;
static_assert(WS_GD + 131072 <= 2 * MiB, "small region");
constexpr size_t WS_H2 = 2 * MiB;
constexpr size_t WS_HT = 5 * MiB;
constexpr size_t WS_HTC = 21 * MiB;
constexpr size_t WS_WIN = 22 * MiB, WS_WOUT = WS_WIN + (size_t)NIN * D * 2, WS_W13 = WS_WOUT + (size_t)D * D * 2, WS_W2 = WS_W13 + (size_t)2 * DFF * D * 2;
static_assert(WS_W2 + (size_t)D * DFF * 2 == 48 * MiB, "weights fill [22,48) MiB");
constexpr size_t WS_XN = 48 * MiB;
constexpr size_t WS_PROJ = 80 * MiB;
constexpr size_t WS_CT = 169 * MiB, WS_CT2 = 185 * MiB;
constexpr size_t WS_OSUM = 193 * MiB;
constexpr size_t WS_RGH = 225 * MiB, WS_RGP = 233 * MiB;
constexpr size_t WS_GS = 241 * MiB, WS_END = 249 * MiB;
constexpr size_t OUT_YS = 8388608, OUT_SGLA = 16777216, OUT_SRG = 18874368, OUT_SHG = 18907136, OUT_END = 21004288;
constexpr int CW_BAR = 4096;
constexpr int RING_BYTES = 131072, LDS_BYTES = 147456, LDSCTL_OFF = LDS_BYTES - 512, MISC_OFF = LDSCTL_OFF + 320;

#define GAS __attribute__((address_space(1)))
#define LAS __attribute__((address_space(3)))
typedef unsigned short bf16;
typedef unsigned v4u __attribute__((ext_vector_type(4)));
typedef unsigned v2u __attribute__((ext_vector_type(2)));
typedef float f32x4 __attribute__((ext_vector_type(4)));
typedef float f32x2 __attribute__((ext_vector_type(2)));
typedef short bf16x8 __attribute__((ext_vector_type(8)));
typedef short bf16x4 __attribute__((ext_vector_type(4)));
typedef GAS unsigned gu32;
#define RLX_AGENT __ATOMIC_RELAXED, __HIP_MEMORY_SCOPE_AGENT
#define LDS_WAIT() asm volatile("s_waitcnt lgkmcnt(0)" ::: "memory")
#define VM_WAIT() asm volatile("s_waitcnt vmcnt(0)" ::: "memory")
__device__ __forceinline__ unsigned f2bf(float f) { unsigned u = __builtin_bit_cast(unsigned, f); return (u + 0x7fffu + ((u >> 16) & 1u)) >> 16; }
__device__ __forceinline__ unsigned pk2(float lo, float hi) { return f2bf(lo) | (f2bf(hi) << 16); }
__device__ __forceinline__ float bf2f(unsigned h) { return __builtin_bit_cast(float, h << 16); }
__device__ __forceinline__ float bflo(unsigned w) { return __builtin_bit_cast(float, w << 16); }
__device__ __forceinline__ float bfhi(unsigned w) { return __builtin_bit_cast(float, w & 0xffff0000u); }
__device__ __forceinline__ float wave_sum(float v) {
#pragma unroll
    for (int o = 1; o < 64; o <<= 1) v += __shfl_xor(v, o);
    return v;
}
__device__ __forceinline__ float sigmoidf_(float x) { return 1.f / (1.f + __expf(-x)); }
#define XB_TMO      128
#define XB_XCNT(j)  (256  + 64 * (j))
#define XB_XSUB(j)  (1280 + 64 * (j))
#define XB_XGEN(j)  (2304 + 64 * (j))
#define XB_TOP      3328
#define XB_TOPGEN   3392
#define XCD_BAR_WORDS 3456
#define XB_SPIN_CAP (1u << 18)

__device__ __forceinline__ unsigned xb_ld(unsigned* p)              { return __hip_atomic_load(p, __ATOMIC_RELAXED, __HIP_MEMORY_SCOPE_AGENT); }
__device__ __forceinline__ unsigned xb_add(unsigned* p, unsigned v) { return __hip_atomic_fetch_add(p, v, __ATOMIC_RELAXED, __HIP_MEMORY_SCOPE_AGENT); }
__device__ __forceinline__ unsigned xb_xcc_id() { return (unsigned)__builtin_amdgcn_s_getreg((3 << 11) | 20) & 0xFu; }
#define XB_SPIN(cond, bar) do { unsigned _sp = 0; while (cond) { __builtin_amdgcn_s_sleep(1); \
    if ((++_sp & 255u) == 0u) { if (xb_ld(&(bar)[XB_TMO])) break; if (_sp > XB_SPIN_CAP) { atomicAdd(&(bar)[XB_TMO], 1u); break; } } } } while (0)

struct XcdBarrier {
    unsigned* bar; unsigned x;
    volatile LAS unsigned* st;
};

__device__ __forceinline__ XcdBarrier xcd_barrier_post(unsigned* bar, volatile LAS unsigned* st) {
    XcdBarrier b; b.bar = bar; b.x = xb_xcc_id(); b.st = st;
    if (threadIdx.x == 0) (void)xb_add(&bar[XB_XCNT(b.x)], 1u);
    return b;
}
__device__ __forceinline__ void xcd_barrier_complete(unsigned* bar, unsigned x, unsigned& nloc, unsigned& nx) {
    const unsigned G = gridDim.x * gridDim.y * gridDim.z;
    unsigned sum, cnt, mine, sp = 0u;
    for (;;) {
        sum = 0u; cnt = 0u; mine = 0u;
#pragma unroll
        for (unsigned j = 0; j < 16; ++j) { const unsigned c = xb_ld(&bar[XB_XCNT(j)]); sum += c; cnt += (c > 0u) ? 1u : 0u; mine = (j == x) ? c : mine; }
        if (sum == G) break;
        __builtin_amdgcn_s_sleep(1);
        if ((++sp & 255u) == 0u) { if (xb_ld(&bar[XB_TMO])) break; if (sp > XB_SPIN_CAP) { atomicAdd(&bar[XB_TMO], 1u); break; } }
    }
    nloc = mine > 0u ? mine : 1u; nx = cnt > 0u ? cnt : 1u;
}

__device__ __forceinline__ void xcd_barrier(const XcdBarrier& b) {
    asm volatile("s_waitcnt vmcnt(0)" ::: "memory");
    __syncthreads();
    if (threadIdx.x == 0) {
        unsigned* bar = b.bar;
        __builtin_amdgcn_s_waitcnt(0);
        unsigned nloc = b.st[0], nx = b.st[1];
        if (nloc == 0u) { xcd_barrier_complete(bar, b.x, nloc, nx); b.st[0] = nloc; b.st[1] = nx; }
        const unsigned old = xb_add(&bar[XB_XSUB(b.x)], 1u);
        const unsigned gen = old / nloc;
        if (old + 1u == (gen + 1u) * nloc) {
            __builtin_amdgcn_fence(__ATOMIC_RELEASE, "agent");
            asm volatile("s_waitcnt vmcnt(0)" ::: "memory");
            const unsigned og = xb_add(&bar[XB_TOP], 1u);
            const unsigned tg = og / nx;
            if (og + 1u == (tg + 1u) * nx) xb_add(&bar[XB_TOPGEN], 1u);
            else XB_SPIN(xb_ld(&bar[XB_TOPGEN]) == tg, bar);
            __builtin_amdgcn_fence(__ATOMIC_ACQUIRE, "agent");
            xb_add(&bar[XB_XGEN(b.x)], 1u);
            asm volatile("s_waitcnt vmcnt(0)" ::: "memory");
        } else {
            XB_SPIN(xb_ld(&bar[XB_XGEN(b.x)]) == gen, bar);
            __builtin_amdgcn_fence(__ATOMIC_ACQUIRE, "agent");
            asm volatile("s_waitcnt vmcnt(0)" ::: "memory");
        }
    }
    __syncthreads();
}
struct Ctx { LAS unsigned char* lds; int tid, lane, wave, vcu, G; };
__device__ __forceinline__ Ctx make_ctx(LAS unsigned char* lds) {
    Ctx C; C.lds = lds; int t = threadIdx.x; asm volatile("" : "+v"(t)); C.tid = t; C.lane = t & 63; C.wave = __builtin_amdgcn_readfirstlane(t >> 6);
    C.G = gridDim.x; { const int bx = blockIdx.x; C.vcu = (C.G % 8 == 0) ? (bx % 8) * (C.G / 8) + bx / 8 : bx; }
    return C;
}
typedef const float* fptr_t;
#define KARG ((const __attribute__((address_space(4))) fptr_t*)__builtin_amdgcn_kernarg_segment_ptr())
#define INP(i) (KARG[(i)])
#define OUTP ((float*)KARG[N_IN])
#define WSP ((unsigned char*)KARG[N_IN + 1])
enum { I_XP = 0, I_XS, I_SGLA, I_SRG, I_SHG, I_C, I_CCTX, I_N1G, I_N2G, I_FNG, I_WMOD, I_BMOD, I_WIN, I_WOUT, I_GLAWG, I_GLABG, I_GLANG,
       I_RGCW, I_RGCB, I_RGWA, I_RGBA, I_RGWX, I_RGBX, I_RGLAM, I_HYCW, I_HYCB, I_HYW1, I_HYB1, I_HYW2, I_HYB2, I_HYW3, I_HYDEC, I_HYSKIP,
       I_HGLOW, I_HGNG, I_FW1, I_FW3, I_FW2, N_IN };

__device__ __forceinline__ void transpose_tile(const float* W, int ldw, int k0, int c0, int nvalid, bf16* WT, int ldt, int r0, LAS float* scr, int lane) {
    const int n_ = lane & 31;
    float tv[32];
    const float* Wp = W + (size_t)(k0 + (lane >> 5)) * ldw + c0 + n_;
#pragma unroll
    for (int i = 0; i < 32; ++i) tv[i] = (n_ < nvalid) ? Wp[(size_t)(2 * i) * ldw] : 0.f;
#pragma unroll
    for (int i = 0; i < 32; ++i) scr[(2 * i + (lane >> 5)) * 33 + n_] = tv[i];
    LDS_WAIT(); asm volatile("" ::: "memory");
    const int c = lane & 7;
#pragma unroll
    for (int j = 0; j < 4; ++j) { const int n = (lane >> 3) + 8 * j; const LAS float* s = scr + (8 * c) * 33 + n;
        v4u o; o.x = pk2(s[0 * 33], s[1 * 33]); o.y = pk2(s[2 * 33], s[3 * 33]); o.z = pk2(s[4 * 33], s[5 * 33]); o.w = pk2(s[6 * 33], s[7 * 33]);
        *(GAS v4u*)(WT + (size_t)(r0 + n) * ldt + k0 + 8 * c) = o; }
    LDS_WAIT(); asm volatile("" ::: "memory");
}
__device__ __forceinline__ void convert_weights(const Ctx& C, int l) {
    LAS float* scr = (LAS float*)(C.lds + C.wave * 16384);
    const int gw = C.vcu * NWAVES + C.wave, NGW = C.G * NWAVES;
    constexpr int I_IN = 16 * 120, I_OUT = 16 * 32, I_13 = 16 * 176, I_2 = 44 * 32, NITEMS = I_IN + I_OUT + I_13 + I_2;
    const float* win = INP(I_WIN) + (size_t)l * D * DIN; const float* wout = INP(I_WOUT) + (size_t)l * D * D;
    const float* w1 = INP(I_FW1) + (size_t)l * D * DFF; const float* w3 = INP(I_FW3) + (size_t)l * D * DFF; const float* w2 = INP(I_FW2) + (size_t)l * DFF * D;
    bf16* WinT = (bf16*)(WSP + WS_WIN); bf16* WoutT = (bf16*)(WSP + WS_WOUT); bf16* W13T = (bf16*)(WSP + WS_W13); bf16* W2T = (bf16*)(WSP + WS_W2);
    for (int it = gw; it < NITEMS; it += NGW) {
        int r = it;
        if (r < I_IN) { const int kb = r / 120, nb = r % 120, n0 = 32 * nb; int src, nv = 32;
            if (n0 < 768) src = 1552 + n0; else if (n0 < 1792) src = n0 - 768; else if (n0 < 2304) src = 1040 + (n0 - 1792); else if (n0 < 3584) src = 2320 + (n0 - 2304);
            else if (n0 == 3584) { src = 1024; nv = 16; } else { src = 0; nv = 0; }
            transpose_tile(win, DIN, 64 * kb, src, nv, WinT, D, n0, scr, C.lane); continue; } r -= I_IN;
        if (r < I_OUT) { const int kb = r / 32, nb = r % 32; transpose_tile(wout, D, 64 * kb, 32 * nb, 32, WoutT, D, 32 * nb, scr, C.lane); continue; } r -= I_OUT;
        if (r < I_13) { const int kb = r / 176, nb = r % 176, n0 = 32 * nb, tile = n0 >> 8, j = n0 & 255;
            transpose_tile(j < 128 ? w1 : w3, DFF, 64 * kb, 128 * tile + (j & 127), 32, W13T, D, n0, scr, C.lane); continue; } r -= I_13;
        { const int kb = r / 32, nb = r % 32; transpose_tile(w2, D, 64 * kb, 32 * nb, 32, W2T, DFF, 32 * nb, scr, C.lane); }
    }
}
__device__ __forceinline__ void mod_gemv(const Ctx& C) {
    LAS float* sc = (LAS float*)C.lds;
    for (int i = C.tid; i < 3072; i += NWAVES * 64) { const int r = i >> 10, k = i & 1023; const float v = (r == 0) ? INP(I_CCTX)[k] : INP(I_C)[(r - 1) * 1024 + k]; sc[i] = v * sigmoidf_(v); }
    __syncthreads();
    float* mod = (float*)(WSP + WS_MOD);
    const int gw = C.vcu * NWAVES + C.wave, NGW = C.G * NWAVES;
    for (int item = gw; item < 2 * 24 * 32; item += NGW) {
        const int kc = item & 31, cc = (item >> 5) % 24, l = item / (24 * 32), col = cc * 256 + 4 * C.lane;
        const float* w = INP(I_WMOD) + ((size_t)l * 1024 + kc * 32) * 6144 + col;
        f32x4 wv[32];
#pragma unroll
        for (int k = 0; k < 32; ++k) wv[k] = *(const f32x4*)(w + (size_t)k * 6144);
        f32x4 a0 = (f32x4){0.f, 0.f, 0.f, 0.f}, a1 = a0, a2 = a0;
#pragma unroll
        for (int k = 0; k < 32; ++k) { a0 += wv[k] * sc[kc * 32 + k]; a1 += wv[k] * sc[1024 + kc * 32 + k]; a2 += wv[k] * sc[2048 + kc * 32 + k]; }
        if (kc == 0) { const f32x4 b = *(const f32x4*)(INP(I_BMOD) + l * 6144 + col); a0 += b; a1 += b; a2 += b; }
        float* m0 = mod + ((size_t)l * 3) * 6144 + col;
#pragma unroll
        for (int e = 0; e < 4; ++e) { atomicAdd(m0 + e, a0[e]); atomicAdd(m0 + 6144 + e, a1[e]); atomicAdd(m0 + 2 * 6144 + e, a2[e]); }
    }
}
__device__ __forceinline__ void h2_rows(const Ctx& C) {
    const int gw = C.vcu * NWAVES + C.wave, NGW = C.G * NWAVES;
    float* H2 = (float*)(WSP + WS_H2);
    for (int rw = gw; rw < 2 * 4352; rw += NGW) {
        const int l = rw / 4352, rr = rw % 4352; const int L = rr < 4096 ? 4096 : 256, pos = rr < 4096 ? rr : rr - 4096;
        float pe = 0.f;
        if (C.lane == 0) pe = (float)pos / (float)(L - 1);
        else if (C.lane < 33) { const int b = (C.lane - 1) & 15; const double band = 1e-4 + (double)b * ((15.0 - 1e-4) / 15.0);
            double x = (double)pos * band / (double)L; x -= floor(x); float s, c; sincospif((float)(2.0 * x), &s, &c); pe = (C.lane < 17) ? c : -s; }
        const float* w1 = INP(I_HYW1) + l * 33 * 64; const float* w2 = INP(I_HYW2) + l * 64 * 64;
        float a = INP(I_HYB1)[l * 64 + C.lane];
#pragma unroll
        for (int i = 0; i < 33; ++i) a += __shfl(pe, i) * w1[i * 64 + C.lane];
        const float h1 = sinf(a);
        float b = INP(I_HYB2)[l * 64 + C.lane];
#pragma unroll 16
        for (int i = 0; i < 64; ++i) b += __shfl(h1, i) * w2[i * 64 + C.lane];
        H2[(size_t)l * 278528 + (rr < 4096 ? (size_t)C.lane * 4096 + pos : (size_t)262144 + C.lane * 256 + pos)] = sinf(b);
    }
}
__device__ __forceinline__ void p0_prologue(const Ctx& C) {
    mod_gemv(C);
    __syncthreads();
    convert_weights(C, 0);
    h2_rows(C);
    const int gt = C.vcu * NWAVES * 64 + C.tid, NGT = C.G * NWAVES * 64;
    float* PE = (float*)(WSP + WS_PE);
    for (int i = gt; i < 64 * 512; i += NGT) { const int p = i >> 9, j = i & 511, jj = j & 255; const float om = expf(-(float)jj * (9.210340371976184f / 256.f)); const float ang = (float)p * om; PE[i] = (j < 256) ? sinf(ang) : cosf(ang); }
    bf16* RGW = (bf16*)(WSP + WS_RGW);
    for (int i = gt; i < 2 * 2 * 2 * 4 * 4096; i += NGT) {
        const int i_ = i & 63, j = (i >> 6) & 63, hb = (i >> 12) & 3, gate = (i >> 14) & 1, d = (i >> 15) & 1, l = i >> 16;
        const float* src = INP(gate ? I_RGWX : I_RGWA) + ((((size_t)l * 2 + d) * 4 + hb) * 64 + i_) * 64 + j;
        RGW[i] = (bf16)f2bf(*src); }
}
__device__ __forceinline__ int cond_row(int m) { return m < MCTX ? 0 : 1 + ((m - MCTX) >> 12); }
template <bool INIT>
__device__ __forceinline__ void norm_rows(const Ctx& C, const float* gamma, const float* modl, int off_sh, int off_sc) {
    const int gw = C.vcu * NWAVES + C.wave, NGW = C.G * NWAVES;
    float* X = OUTP; bf16* XN = (bf16*)(WSP + WS_XN); const float* PE = (const float*)(WSP + WS_PE);
    for (int m = gw; m < M; m += NGW) {
        const int r = cond_row(m); const float* md = modl + r * 6144;
        f32x4 v[4]; float ss = 0.f;
#pragma unroll
        for (int j = 0; j < 4; ++j) { const int col = 256 * j + 4 * C.lane;
            if (INIT) { if (m < MCTX) v[j] = *(const f32x4*)(INP(I_XP) + (size_t)m * D + col);
                else { const int t = (m - MCTX) & 4095; const int p = (j < 2) ? (t >> 6) : (t & 63);
                    v[j] = *(const f32x4*)(INP(I_XS) + (size_t)(m - MCTX) * D + col) + *(const f32x4*)(PE + p * 512 + (col & 511)); }
                *(f32x4*)(X + (size_t)m * D + col) = v[j]; }
            else v[j] = *(const f32x4*)(X + (size_t)m * D + col);
            ss += (v[j].x * v[j].x + v[j].y * v[j].y) + (v[j].z * v[j].z + v[j].w * v[j].w); }
        const float rstd = 1.f / sqrtf(wave_sum(ss) * (1.f / D) + EPS);
#pragma unroll
        for (int j = 0; j < 4; ++j) { const int col = 256 * j + 4 * C.lane;
            const f32x4 g = *(const f32x4*)(gamma + col), sc = *(const f32x4*)(md + off_sc + col), sh = *(const f32x4*)(md + off_sh + col);
            const f32x4 u = (v[j] * rstd) * g * (sc + 1.f) + sh;
            v2u o; o.x = pk2(u.x, u.y); o.y = pk2(u.z, u.w);
            *(GAS v2u*)(XN + (size_t)m * D + col) = o; }
    }
}
__device__ __forceinline__ void final_norm(const Ctx& C) {
    const int gw = C.vcu * NWAVES + C.wave, NGW = C.G * NWAVES; float* X = OUTP; const float* gamma = INP(I_FNG);
    for (int m = gw; m < M; m += NGW) {
        f32x4 v[4]; float ss = 0.f;
#pragma unroll
        for (int j = 0; j < 4; ++j) { v[j] = *(const f32x4*)(X + (size_t)m * D + 256 * j + 4 * C.lane); ss += (v[j].x * v[j].x + v[j].y * v[j].y) + (v[j].z * v[j].z + v[j].w * v[j].w); }
        const float rstd = 1.f / sqrtf(wave_sum(ss) * (1.f / D) + EPS);
#pragma unroll
        for (int j = 0; j < 4; ++j) { const int col = 256 * j + 4 * C.lane; *(f32x4*)(X + (size_t)m * D + col) = (v[j] * rstd) * *(const f32x4*)(gamma + col); }
    }
}
__device__ __forceinline__ void hyena_filters(const Ctx& C) {
    LAS float* w3s = (LAS float*)C.lds;
    LAS float* red = w3s + 2048;
    const float* H2 = (const float*)(WSP + WS_H2);
    for (int u = C.vcu; u < 256 + 32; u += C.G) {
        __syncthreads();
        if (u < 256) {
            const int l = u >> 7, f0 = (u & 127) * 4;
            if (C.tid < 256) { const int j = C.tid >> 2, e = C.tid & 3; w3s[j * 4 + e] = INP(I_HYW3)[((size_t)l * 64 + j) * 512 + f0 + e]; }
            __syncthreads();
            float hv[8][4];
#pragma unroll
            for (int i = 0; i < 8; ++i)
#pragma unroll
                for (int e = 0; e < 4; ++e) hv[i][e] = 0.f;
            const float* hb = H2 + (size_t)l * 278528 + C.tid;
#pragma unroll 4
            for (int j = 0; j < 64; ++j) { const f32x4 wv = *(const LAS f32x4*)(w3s + j * 4);
#pragma unroll
                for (int i = 0; i < 8; ++i) { const float h = hb[(size_t)j * 4096 + 512 * i]; hv[i][0] += h * wv.x; hv[i][1] += h * wv.y; hv[i][2] += h * wv.z; hv[i][3] += h * wv.w; } }
            float sm[4];
#pragma unroll
            for (int e = 0; e < 4; ++e) { const float dec = INP(I_HYDEC)[l * 512 + f0 + e]; float s = 0.f;
#pragma unroll
                for (int i = 0; i < 8; ++i) { const int t = C.tid + 512 * i; const float dist = fabsf((float)(t - 2048)) * (1.f / 2048.f); hv[i][e] *= expf(-dist * dec); s += fabsf(hv[i][e]); }
                sm[e] = wave_sum(s); }
            if (C.lane == 0) {
#pragma unroll
                for (int e = 0; e < 4; ++e) red[C.wave * 16 + e] = sm[e]; }
            __syncthreads();
#pragma unroll
            for (int e = 0; e < 4; ++e) { float tot = 0.f;
#pragma unroll
                for (int w8 = 0; w8 < 8; ++w8) tot += red[w8 * 16 + e];
                const float inv = 1.f / tot; float* dst = (float*)(WSP + WS_HT) + ((size_t)l * 512 + f0 + e) * 4096 + C.tid;
#pragma unroll
                for (int i = 0; i < 8; ++i) dst[512 * i] = hv[i][e] * inv; }
        } else {
            const int uu = u - 256, l = uu >> 4, f0 = (uu & 15) * 32, t = C.tid & 255, fh = C.tid >> 8;
            for (int i = C.tid; i < 2048; i += 512) { const int j = i >> 5, e = i & 31; w3s[i] = INP(I_HYW3)[((size_t)l * 64 + j) * 512 + f0 + e]; }
            __syncthreads();
            float hv[16];
#pragma unroll
            for (int e = 0; e < 16; ++e) hv[e] = 0.f;
            const float* hb = H2 + (size_t)l * 278528 + 262144 + t;
#pragma unroll 4
            for (int j = 0; j < 64; ++j) { const float h = hb[j * 256];
#pragma unroll
                for (int q = 0; q < 4; ++q) { const f32x4 wv = *(const LAS f32x4*)(w3s + j * 32 + 16 * fh + 4 * q); hv[4 * q] += h * wv.x; hv[4 * q + 1] += h * wv.y; hv[4 * q + 2] += h * wv.z; hv[4 * q + 3] += h * wv.w; } }
            const float dist = fabsf((float)(t - 128)) * (1.f / 128.f);
#pragma unroll
            for (int e = 0; e < 16; ++e) { hv[e] *= expf(-dist * INP(I_HYDEC)[l * 512 + f0 + 16 * fh + e]); const float s = wave_sum(fabsf(hv[e])); if (C.lane == 0) red[C.wave * 16 + e] = s; }
            __syncthreads();
#pragma unroll
            for (int e = 0; e < 16; ++e) { const float tot = red[(4 * fh + 0) * 16 + e] + red[(4 * fh + 1) * 16 + e] + red[(4 * fh + 2) * 16 + e] + red[(4 * fh + 3) * 16 + e];
                ((float*)(WSP + WS_HTC))[((size_t)l * 512 + f0 + 16 * fh + e) * 256 + t] = hv[e] / tot; }
        }
    }
}
__device__ __forceinline__ float gelu_tanh(float x) { const float u = 0.7978845608028654f * (x + 0.044715f * x * x * x); const float t = 1.f - 2.f / (1.f + __expf(2.f * u)); return 0.5f * x * (1.f + t); }
__device__ __forceinline__ float softplusf_(float z) { return fmaxf(z, 0.f) + log1pf(__expf(-fabsf(z))); }
__device__ __forceinline__ bf16x8 pack_bf16x8(f32x4 a, f32x4 b) {
    v4u w; w.x = pk2(a.x, a.y); w.y = pk2(a.z, a.w); w.z = pk2(b.x, b.y); w.w = pk2(b.z, b.w);
    return __builtin_bit_cast(bf16x8, w);
}
__device__ __forceinline__ void rg_main(const Ctx& C, int l, int u) {
    const int seg = u >> 2, hb = u & 3; const bool lat = seg >= 32; const int m0 = seg * 256;
    const int sbeg = lat ? MCTX + ((seg - 32) >> 4) * 4096 : m0, send = lat ? sbeg + 4096 : m0 + 256;
    LAS float* xc = (LAS float*)C.lds; LAS float* hs = xc + 256 * 68;
    const bf16* PROJ = (const bf16*)(WSP + WS_PROJ);
    {
        const int t = C.tid >> 1, c0 = 32 * (C.tid & 1), chg = 64 * hb + c0;
        float acc[32];
        const float* cb = INP(I_RGCB) + l * 256 + chg;
#pragma unroll
        for (int e = 0; e < 32; e += 4) { const f32x4 b = *(const f32x4*)(cb + e); acc[e] = b.x; acc[e + 1] = b.y; acc[e + 2] = b.z; acc[e + 3] = b.w; }
#pragma unroll
        for (int j = 0; j < 4; ++j) { const int mr = m0 + t - 2 + j;
            if (mr >= sbeg && mr < send) { const v4u* xp = (const v4u*)(PROJ + (size_t)mr * pg8::PROJ_LD + 1024 + chg); const float* wp = INP(I_RGCW) + (l * 4 + j) * 256 + chg;
#pragma unroll
                for (int q = 0; q < 4; ++q) { const v4u xv = xp[q]; const f32x4 w0 = *(const f32x4*)(wp + 8 * q), w1 = *(const f32x4*)(wp + 8 * q + 4);
                    acc[8 * q + 0] += w0.x * bflo(xv.x); acc[8 * q + 1] += w0.y * bfhi(xv.x); acc[8 * q + 2] += w0.z * bflo(xv.y); acc[8 * q + 3] += w0.w * bfhi(xv.y);
                    acc[8 * q + 4] += w1.x * bflo(xv.z); acc[8 * q + 5] += w1.y * bfhi(xv.z); acc[8 * q + 6] += w1.z * bflo(xv.w); acc[8 * q + 7] += w1.w * bfhi(xv.w); } } }
#pragma unroll
        for (int e = 0; e < 32; e += 4) { *(LAS f32x4*)(xc + t * 68 + c0 + e) = (f32x4){acc[e], acc[e + 1], acc[e + 2], acc[e + 3]}; *(LAS f32x4*)(hs + t * 68 + c0 + e) = (f32x4){0.f, 0.f, 0.f, 0.f}; }
    }
    __syncthreads();
    {
        const int dir = C.wave >> 2, nt = C.wave & 3, cl = C.lane & 15, g = C.lane >> 4, ch = 16 * nt + cl, chg = 64 * hb + ch;
        const bf16* wb = (const bf16*)(WSP + WS_RGW) + ((size_t)(((l * 2 + dir) * 2 + 0) * 4 + hb) * 64 + ch) * 64 + 8 * g;
        const bf16x8 Ba0 = *(const bf16x8*)(wb), Ba1 = *(const bf16x8*)(wb + 32), Bx0 = *(const bf16x8*)(wb + 16384), Bx1 = *(const bf16x8*)(wb + 16384 + 32);
        const float ba = INP(I_RGBA)[(l * 2 + dir) * 256 + chg], bx = INP(I_RGBX)[(l * 2 + dir) * 256 + chg];
        const float c1 = -8.f * softplusf_(-INP(I_RGLAM)[(l * 2 + dir) * 256 + chg]);
        bf16* RGP = (bf16*)(WSP + WS_RGP) + (size_t)dir * 8192 * 256;
        float carry = 0.f, pc = 1.f;
#pragma unroll 1
        for (int it = 0; it < 16; ++it) {
            const int t0 = 16 * (dir ? 15 - it : it);
            const LAS float* xr = xc + (t0 + cl) * 68 + 8 * g;
            const bf16x8 A0 = pack_bf16x8(*(const LAS f32x4*)(xr), *(const LAS f32x4*)(xr + 4)), A1 = pack_bf16x8(*(const LAS f32x4*)(xr + 32), *(const LAS f32x4*)(xr + 36));
            f32x4 ar = (f32x4){0.f, 0.f, 0.f, 0.f}, ax = ar;
            ar = __builtin_amdgcn_mfma_f32_16x16x32_bf16(A0, Ba0, ar, 0, 0, 0); ar = __builtin_amdgcn_mfma_f32_16x16x32_bf16(A1, Ba1, ar, 0, 0, 0);
            ax = __builtin_amdgcn_mfma_f32_16x16x32_bf16(A0, Bx0, ax, 0, 0, 0); ax = __builtin_amdgcn_mfma_f32_16x16x32_bf16(A1, Bx1, ax, 0, 0, 0);
            float a[4], uu[4];
#pragma unroll
            for (int r = 0; r < 4; ++r) { const float xv = xc[(t0 + 4 * g + r) * 68 + ch]; const float rr = sigmoidf_(ar[r] + ba), ii = sigmoidf_(ax[r] + bx);
                const float la = c1 * rr; a[r] = __expf(la); uu[r] = sqrtf(-expm1f(2.f * la)) * ii * xv; }
            const float Aloc = (a[0] * a[1]) * (a[2] * a[3]);
            const float Uloc = dir ? ((uu[3] * a[2] + uu[2]) * a[1] + uu[1]) * a[0] + uu[0] : ((uu[0] * a[1] + uu[1]) * a[2] + uu[2]) * a[3] + uu[3];
            float hin = carry, pin = pc;
            if (!dir) {
#pragma unroll
                for (int gp = 0; gp < 3; ++gp) { const float Ag = __shfl(Aloc, cl + 16 * gp), Ug = __shfl(Uloc, cl + 16 * gp); if (gp < g) { hin = Ag * hin + Ug; pin *= Ag; } }
            } else {
#pragma unroll
                for (int gp = 3; gp > 0; --gp) { const float Ag = __shfl(Aloc, cl + 16 * gp), Ug = __shfl(Uloc, cl + 16 * gp); if (gp > g) { hin = Ag * hin + Ug; pin *= Ag; } }
            }
            float h[4], p[4];
            if (!dir) { h[0] = a[0] * hin + uu[0]; h[1] = a[1] * h[0] + uu[1]; h[2] = a[2] * h[1] + uu[2]; h[3] = a[3] * h[2] + uu[3];
                        p[0] = pin * a[0]; p[1] = p[0] * a[1]; p[2] = p[1] * a[2]; p[3] = p[2] * a[3];
                        carry = __shfl(h[3], 48 + cl); pc = __shfl(p[3], 48 + cl); }
            else      { h[3] = a[3] * hin + uu[3]; h[2] = a[2] * h[3] + uu[2]; h[1] = a[1] * h[2] + uu[1]; h[0] = a[0] * h[1] + uu[0];
                        p[3] = pin * a[3]; p[2] = p[3] * a[2]; p[1] = p[2] * a[1]; p[0] = p[1] * a[0];
                        carry = __shfl(h[0], cl); pc = __shfl(p[0], cl); }
#pragma unroll
            for (int r = 0; r < 4; ++r) { const int t = t0 + 4 * g + r;
                (void)__hip_atomic_fetch_add(hs + t * 68 + ch, h[r], __ATOMIC_RELAXED, __HIP_MEMORY_SCOPE_WORKGROUP);
                if (lat) RGP[(size_t)(m0 - MCTX + t) * 256 + chg] = (bf16)f2bf(p[r]); }
        }
        if (g == 0) {
            if (lat) { float* ag = (float*)(WSP + WS_RGAGG) + ((size_t)((seg - 32) * 2 + dir) * 256 + chg) * 2; ag[0] = pc; ag[1] = carry; }
            else OUTP[OUT_SRG + ((size_t)(seg * 2 + l) * 2 + dir) * 256 + chg] = carry;
        }
    }
    __syncthreads();
    {
        const int t = C.tid >> 1, c0 = 32 * (C.tid & 1), chg = 64 * hb + c0, m = m0 + t;
        if (!lat) {
            const v4u* gp = (const v4u*)(PROJ + (size_t)m * pg8::PROJ_LD + 1280 + chg); bf16* yp = (bf16*)(WSP + WS_XN) + (size_t)m * 1024 + 256 + chg;
#pragma unroll
            for (int q = 0; q < 4; ++q) { const v4u gv = gp[q]; const f32x4 h0 = *(const LAS f32x4*)(hs + t * 68 + c0 + 8 * q), h1 = *(const LAS f32x4*)(hs + t * 68 + c0 + 8 * q + 4);
                v4u o; o.x = pk2(h0.x * gelu_tanh(bflo(gv.x)), h0.y * gelu_tanh(bfhi(gv.x))); o.y = pk2(h0.z * gelu_tanh(bflo(gv.y)), h0.w * gelu_tanh(bfhi(gv.y)));
                o.z = pk2(h1.x * gelu_tanh(bflo(gv.z)), h1.y * gelu_tanh(bfhi(gv.z))); o.w = pk2(h1.z * gelu_tanh(bflo(gv.w)), h1.w * gelu_tanh(bfhi(gv.w)));
                *(GAS v4u*)(yp + 8 * q) = o; }
        } else {
            float* hp = (float*)(WSP + WS_RGH) + (size_t)(m - MCTX) * 256 + chg;
#pragma unroll
            for (int q = 0; q < 8; ++q) *(f32x4*)(hp + 4 * q) = *(const LAS f32x4*)(hs + t * 68 + c0 + 4 * q);
        }
    }
    __syncthreads();
}
__device__ __forceinline__ void rg_corr(const Ctx& C, int l, int u) {
    const int segl = u >> 2, cg = u & 3, b = segl >> 4, j = segl & 15;
    LAS float* hin = (LAS float*)C.lds;
    __syncthreads();
    if (C.tid < 128) { const int dir = C.tid >> 6, c = C.tid & 63, chg = 64 * cg + c;
        float h = INP(I_SRG)[((size_t)(b * 2 + l) * 2 + dir) * 256 + chg];
        const float* ag = (const float*)(WSP + WS_RGAGG);
        if (dir == 0) { for (int i = 0; i < j; ++i) { const float* a2 = ag + ((size_t)((b * 16 + i) * 2 + 0) * 256 + chg) * 2; h = a2[0] * h + a2[1]; } }
        else { for (int i = 15; i > j; --i) { const float* a2 = ag + ((size_t)((b * 16 + i) * 2 + 1) * 256 + chg) * 2; h = a2[0] * h + a2[1]; } }
        hin[dir * 64 + c] = h; }
    __syncthreads();
    const int t = C.tid >> 1, c0 = 32 * (C.tid & 1), chg = 64 * cg + c0, tl = segl * 256 + t, m = MCTX + tl;
    const bf16* PROJ = (const bf16*)(WSP + WS_PROJ);
    const v4u* gp = (const v4u*)(PROJ + (size_t)m * pg8::PROJ_LD + 1280 + chg); bf16* yp = (bf16*)(WSP + WS_XN) + (size_t)m * 1024 + 256 + chg;
    const float* hp = (const float*)(WSP + WS_RGH) + (size_t)tl * 256 + chg;
    const v4u* pf = (const v4u*)((const bf16*)(WSP + WS_RGP) + (size_t)tl * 256 + chg); const v4u* pb = (const v4u*)((const bf16*)(WSP + WS_RGP) + (size_t)(8192 + tl) * 256 + chg);
#pragma unroll
    for (int q = 0; q < 4; ++q) { const v4u gv = gp[q], fv = pf[q], bv = pb[q]; const f32x4 h0 = *(const f32x4*)(hp + 8 * q), h1 = *(const f32x4*)(hp + 8 * q + 4);
        const LAS float* hf = hin + c0 + 8 * q; const LAS float* hbk = hin + 64 + c0 + 8 * q;
        float hv[8];
        hv[0] = h0.x + bflo(fv.x) * hf[0] + bflo(bv.x) * hbk[0]; hv[1] = h0.y + bfhi(fv.x) * hf[1] + bfhi(bv.x) * hbk[1];
        hv[2] = h0.z + bflo(fv.y) * hf[2] + bflo(bv.y) * hbk[2]; hv[3] = h0.w + bfhi(fv.y) * hf[3] + bfhi(bv.y) * hbk[3];
        hv[4] = h1.x + bflo(fv.z) * hf[4] + bflo(bv.z) * hbk[4]; hv[5] = h1.y + bfhi(fv.z) * hf[5] + bfhi(bv.z) * hbk[5];
        hv[6] = h1.z + bflo(fv.w) * hf[6] + bflo(bv.w) * hbk[6]; hv[7] = h1.w + bfhi(fv.w) * hf[7] + bfhi(bv.w) * hbk[7];
        v4u o; o.x = pk2(hv[0] * gelu_tanh(bflo(gv.x)), hv[1] * gelu_tanh(bfhi(gv.x))); o.y = pk2(hv[2] * gelu_tanh(bflo(gv.y)), hv[3] * gelu_tanh(bfhi(gv.y)));
        o.z = pk2(hv[4] * gelu_tanh(bflo(gv.z)), hv[5] * gelu_tanh(bfhi(gv.z))); o.w = pk2(hv[6] * gelu_tanh(bflo(gv.w)), hv[7] * gelu_tanh(bfhi(gv.w)));
        *(GAS v4u*)(yp + 8 * q) = o; }
}
typedef short s16x4 __attribute__((ext_vector_type(4)));
template <int CTRL> __device__ __forceinline__ float dpp_mov_id1(float x) { return __builtin_bit_cast(float, __builtin_amdgcn_update_dpp(0x3f800000, __builtin_bit_cast(int, x), CTRL, 0xf, 0xf, false)); }
__device__ __forceinline__ float row_cumprod16(float x) { x *= dpp_mov_id1<0x111>(x); x *= dpp_mov_id1<0x112>(x); x *= dpp_mov_id1<0x114>(x); x *= dpp_mov_id1<0x118>(x); return x; }
__device__ __forceinline__ s16x4 pack_bf16x4(float a, float b, float c, float d) { v2u w; w.x = pk2(a, b); w.y = pk2(c, d); return __builtin_bit_cast(s16x4, w); }
__device__ __forceinline__ bf16x8 pack_bf16x8s(float a0, float a1, float a2, float a3, float a4, float a5, float a6, float a7) {
    v4u w; w.x = pk2(a0, a1); w.y = pk2(a2, a3); w.z = pk2(a4, a5); w.w = pk2(a6, a7); return __builtin_bit_cast(bf16x8, w); }

#define GLA_LOAD_RAW(R, cidx) do { const int ts_ = dir ? 255 - (16 * (cidx) + tt) : 16 * (cidx) + tt; const bf16* row_ = PROJ + (size_t)(m0 + ts_) * pg8::PROJ_LD; \
        _Pragma("unroll") for (int i_ = 0; i_ < 4; ++i_) { R.k[i_] = *(const v2u*)(row_ + kcol + hc + 16 * i_ + 4 * g); } \
        R.v0 = *(const v4u*)(row_ + vcol + hc + 16 * g); R.v1 = *(const v4u*)(row_ + vcol + hc + 16 * g + 8); if (mixer == 0) R.lr = *(const v2u*)(row_ + 2816 + 4 * g); } while (0)
struct GlaRaw { v2u k[4]; v4u v0, v1; v2u lr; };
template <bool MAIN, int mixer>
__device__ __forceinline__ void gla3_unit(const Ctx& C, int l, int seg, int head_arg) {
    const int head = MAIN ? (C.wave >> 1) : head_arg, dir = MAIN ? (C.wave & 1) : (C.wave >> 2), quarter = C.wave & 3;
    const int lane = C.lane, tt = lane & 15, g = lane >> 4;
    LAS bf16* Vt = (LAS bf16*)(C.lds + C.wave * 5376); LAS bf16* Kt = Vt + 16 * 80; LAS float* ctab = (LAS float*)(Kt + 16 * 80);
    const bool lat = seg >= 32; const int m0 = seg * 256, hc = 64 * head;
    const bf16* PROJ = (const bf16*)(WSP + WS_PROJ);
    s16x4 WgA[4];
#pragma unroll
    for (int i = 0; i < 4; ++i) WgA[i] = (s16x4){0, 0, 0, 0};
    if (mixer == 0) {
        const float* wg = INP(I_GLAWG) + (size_t)(l * 2 + dir) * 16 * 256 + hc;
#pragma unroll
        for (int i = 0; i < 4; ++i) WgA[i] = pack_bf16x4(wg[(4 * g + 0) * 256 + 16 * i + tt], wg[(4 * g + 1) * 256 + 16 * i + tt], wg[(4 * g + 2) * 256 + 16 * i + tt], wg[(4 * g + 3) * 256 + 16 * i + tt]);
        ctab[lane] = INP(I_GLABG)[(l * 2 + dir) * 256 + hc + lane];
    } else ctab[lane] = (l > 0) ? sigmoidf_(INP(I_HGLOW)[256 + hc + lane] - INP(I_HGLOW)[hc + lane]) : 0.f;
    f32x4 S[4][4];
    const unsigned soff0 = (unsigned)((4 * g) * 64 + tt);
#pragma unroll
    for (int kt = 0; kt < 4; ++kt)
#pragma unroll
        for (int vt = 0; vt < 4; ++vt) S[kt][vt] = (f32x4){0.f, 0.f, 0.f, 0.f};
    if (MAIN && lat) {
        const int segl = seg - 32, b = segl >> 4, jseg = segl & 15;
        const float* st = INP(mixer ? I_SHG : I_SGLA) + ((size_t)(((b * 2 + l) * 2 + dir) * 4 + head) * 64) * 64;
#pragma unroll
        for (int kt = 0; kt < 4; ++kt)
#pragma unroll
            for (int r = 0; r < 4; ++r) { unsigned o = soff0 + (unsigned)((16 * kt + r) * 64); asm volatile("" : "+v"(o) :: "memory");
#pragma unroll
                for (int vt = 0; vt < 4; ++vt) S[kt][vt][r] = st[o + 16 * vt]; }
        const float* GS = (const float*)(WSP + WS_GS); const float* GD = (const float*)(WSP + WS_GD);
        const int i0 = dir ? 15 : 0, di = dir ? -1 : 1;
#pragma unroll 1
        for (int i = i0; i != jseg; i += di) { const size_t ub = (size_t)((((b * 16 + i) * 2 + mixer) * 4 + head) * 2 + dir) * 64;
            const float* GSu = GS + ub * 64;
#pragma unroll
            for (int kt = 0; kt < 4; ++kt) { const f32x4 dv = *(const f32x4*)(GD + ub + 16 * kt + 4 * g);
#pragma unroll
                for (int r = 0; r < 4; ++r) { unsigned o = soff0 + (unsigned)((16 * kt + r) * 64); asm volatile("" : "+v"(o) :: "memory");
#pragma unroll
                    for (int vt = 0; vt < 4; ++vt) S[kt][vt][r] = dv[r] * S[kt][vt][r] + GSu[o + 16 * vt]; } } }
    }
    float dtot[4][4];
#pragma unroll
    for (int i = 0; i < 4; ++i)
#pragma unroll
        for (int e = 0; e < 4; ++e) dtot[i][e] = 1.f;
    const int qcol = mixer ? 1536 : 0, kcol = mixer ? (dir ? 2048 : 1792) : 256, vcol = mixer ? 2304 : 512, gcol = mixer ? 2560 : 768, ycol = mixer ? 768 : 0;
    float* OS = (float*)(WSP + WS_OSUM) + 256 * mixer + hc;
    bf16* Yb = (bf16*)(WSP + WS_XN) + ycol + hc;
    f32x4 gnv = (f32x4){0.f, 0.f, 0.f, 0.f};
    if (MAIN) { const float* gn = INP(mixer ? I_HGNG : I_GLANG) + l * 256 + hc + tt; gnv = (f32x4){gn[0], gn[16], gn[32], gn[48]}; }
    const int trq = tt >> 2, trp = tt & 3;
    constexpr int NCH = MAIN ? 16 : 4; const int cbase = MAIN ? 0 : 4 * quarter;
    GlaRaw cur; GLA_LOAD_RAW(cur, cbase);
#pragma unroll 1
    for (int ci = 0; ci < NCH; ++ci) {
        const int c = cbase + ci;
        GlaRaw nxt; { const int cn = cbase + (ci + 1 < NCH ? ci + 1 : ci); GLA_LOAD_RAW(nxt, cn); }
        if (MAIN && ci == 8) { VM_WAIT(); __syncthreads(); }
        *(LAS v4u*)(Vt + tt * 80 + 16 * g) = cur.v0; *(LAS v4u*)(Vt + tt * 80 + 16 * g + 8) = cur.v1;
        v2u qraw[4];
        if (MAIN) { const int ts_ = dir ? 255 - (16 * c + tt) : 16 * c + tt; const bf16* row_ = PROJ + (size_t)(m0 + ts_) * pg8::PROJ_LD;
#pragma unroll
            for (int i = 0; i < 4; ++i) qraw[i] = *(const v2u*)(row_ + qcol + hc + 16 * i + 4 * g); }
        float a[4][4], kk[4][4], qq[4][4];
        if (mixer == 0) {
            const s16x4 lrb = __builtin_bit_cast(s16x4, cur.lr);
#pragma unroll
            for (int i = 0; i < 4; ++i) { const f32x4 x = __builtin_amdgcn_mfma_f32_16x16x16bf16_1k(WgA[i], lrb, *(const LAS f32x4*)(ctab + 16 * i + 4 * g), 0, 0, 0);
#pragma unroll
                for (int e = 0; e < 4; ++e) { const float xe = fmaxf(x[e], -60.f); a[i][e] = __builtin_amdgcn_exp2f(-0.0625f * __builtin_amdgcn_logf(1.f + __expf(-xe))); }
                kk[i][0] = bflo(cur.k[i].x); kk[i][1] = bfhi(cur.k[i].x); kk[i][2] = bflo(cur.k[i].y); kk[i][3] = bfhi(cur.k[i].y);
                if (MAIN) { qq[i][0] = 0.125f * bflo(qraw[i].x); qq[i][1] = 0.125f * bfhi(qraw[i].x); qq[i][2] = 0.125f * bflo(qraw[i].y); qq[i][3] = 0.125f * bfhi(qraw[i].y); } }
        } else {
#pragma unroll
            for (int i = 0; i < 4; ++i) { float fl[4] = {bflo(cur.k[i].x), bfhi(cur.k[i].x), bflo(cur.k[i].y), bfhi(cur.k[i].y)}; const f32x4 lbq = *(const LAS f32x4*)(ctab + 16 * i + 4 * g);
#pragma unroll
                for (int e = 0; e < 4; ++e) { const float ef = __expf(-fmaxf(fl[e], -80.f)); const float sg = __builtin_amdgcn_rcpf(1.f + ef); const float sn = ef * sg;
                    a[i][e] = lbq[e] + (1.f - lbq[e]) * sg; kk[i][e] = (1.f - lbq[e]) * sn; }
                if (MAIN) { float dq[4] = {bflo(qraw[i].x), bfhi(qraw[i].x), bflo(qraw[i].y), bfhi(qraw[i].y)};
#pragma unroll
                    for (int e = 0; e < 4; ++e) qq[i][e] = dq[e] * __builtin_amdgcn_rcpf(1.f + __expf(-dq[e])); } }
        }
        float Aend[4][4]; bf16x8 qf[2], kf[2];
#pragma unroll
        for (int i = 0; i < 4; ++i) { float qh[4], kh_[4], kt_[4];
#pragma unroll
            for (int e = 0; e < 4; ++e) { const float A = row_cumprod16(a[i][e]); Aend[i][e] = __shfl(A, (lane & 48) | 15); const float rA = __builtin_amdgcn_rcpf(A);
                kh_[e] = kk[i][e] * rA; kt_[e] = kh_[e] * Aend[i][e]; if (MAIN) qh[e] = qq[i][e] * A; if (!MAIN) dtot[i][e] *= Aend[i][e]; }
            *(LAS s16x4*)(Kt + tt * 80 + 16 * i + 4 * g) = pack_bf16x4(kt_[0], kt_[1], kt_[2], kt_[3]);
            if (MAIN) { const v2u qw = __builtin_bit_cast(v2u, pack_bf16x4(qh[0], qh[1], qh[2], qh[3])), kw = __builtin_bit_cast(v2u, pack_bf16x4(kh_[0], kh_[1], kh_[2], kh_[3]));
                v4u tq = __builtin_bit_cast(v4u, qf[i >> 1]), tk = __builtin_bit_cast(v4u, kf[i >> 1]);
                if (i & 1) { tq.z = qw.x; tq.w = qw.y; tk.z = kw.x; tk.w = kw.y; } else { tq.x = qw.x; tq.y = qw.y; tk.x = kw.x; tk.y = kw.y; }
                qf[i >> 1] = __builtin_bit_cast(bf16x8, tq); kf[i >> 1] = __builtin_bit_cast(bf16x8, tk); } }
        float po[4][4]; unsigned short gz[4][4];
        if (MAIN && ci >= 8) {
#pragma unroll
            for (int r = 0; r < 4; ++r) { const int tr = 4 * g + r; const int tsr = dir ? 255 - (16 * c + tr) : 16 * c + tr; const unsigned mo = (unsigned)(m0 + tsr);
#pragma unroll
                for (int vt = 0; vt < 4; ++vt) { po[vt][r] = OS[mo * 512u + (unsigned)tt + 16u * vt]; gz[vt][r] = PROJ[mo * (unsigned)pg8::PROJ_LD + (unsigned)(gcol + hc + 16 * vt + tt)]; } }
        }
        s16x4 Vb[4], Kb[4];
#pragma unroll
        for (int t4 = 0; t4 < 4; ++t4) { Vb[t4] = __builtin_amdgcn_ds_read_tr16_b64_v4i16((LAS s16x4*)(Vt + (4 * g + trq) * 80 + 16 * t4 + 4 * trp));
                                           Kb[t4] = __builtin_amdgcn_ds_read_tr16_b64_v4i16((LAS s16x4*)(Kt + (4 * g + trq) * 80 + 16 * t4 + 4 * trp)); }
        if (MAIN) {
            f32x4 pa = (f32x4){0.f, 0.f, 0.f, 0.f};
            pa = __builtin_amdgcn_mfma_f32_16x16x32_bf16(kf[0], qf[0], pa, 0, 0, 0); pa = __builtin_amdgcn_mfma_f32_16x16x32_bf16(kf[1], qf[1], pa, 0, 0, 0);
            const s16x4 Pa = pack_bf16x4(4 * g + 0 <= tt ? pa[0] : 0.f, 4 * g + 1 <= tt ? pa[1] : 0.f, 4 * g + 2 <= tt ? pa[2] : 0.f, 4 * g + 3 <= tt ? pa[3] : 0.f);
            f32x4 ov[4];
#pragma unroll
            for (int vt = 0; vt < 4; ++vt) { f32x4 o = (f32x4){0.f, 0.f, 0.f, 0.f};
                o = __builtin_amdgcn_mfma_f32_16x16x16bf16_1k(Pa, Vb[vt], o, 0, 0, 0);
                const bf16x8 sb0 = pack_bf16x8s(S[0][vt][0], S[0][vt][1], S[0][vt][2], S[0][vt][3], S[1][vt][0], S[1][vt][1], S[1][vt][2], S[1][vt][3]);
                const bf16x8 sb1 = pack_bf16x8s(S[2][vt][0], S[2][vt][1], S[2][vt][2], S[2][vt][3], S[3][vt][0], S[3][vt][1], S[3][vt][2], S[3][vt][3]);
                o = __builtin_amdgcn_mfma_f32_16x16x32_bf16(qf[0], sb0, o, 0, 0, 0); ov[vt] = __builtin_amdgcn_mfma_f32_16x16x32_bf16(qf[1], sb1, o, 0, 0, 0); }
            if (ci < 8) {
#pragma unroll
                for (int r = 0; r < 4; ++r) { const int tr = 4 * g + r; const int tsr = dir ? 255 - (16 * c + tr) : 16 * c + tr; const unsigned mo = (unsigned)(m0 + tsr);
#pragma unroll
                    for (int vt = 0; vt < 4; ++vt) OS[mo * 512u + (unsigned)tt + 16u * vt] = ov[vt][r]; }
            } else {
#pragma unroll
                for (int r = 0; r < 4; ++r) { float ss = 0.f;
#pragma unroll
                    for (int vt = 0; vt < 4; ++vt) { ov[vt][r] += po[vt][r]; ss += ov[vt][r] * ov[vt][r]; }
                    ss += __shfl_xor(ss, 1); ss += __shfl_xor(ss, 2); ss += __shfl_xor(ss, 4); ss += __shfl_xor(ss, 8);
                    const float rstd = 1.f / sqrtf(ss * (1.f / 64.f) + EPS);
                    const int tr = 4 * g + r; const int tsr = dir ? 255 - (16 * c + tr) : 16 * c + tr; const unsigned mo = (unsigned)(m0 + tsr);
#pragma unroll
                    for (int vt = 0; vt < 4; ++vt) { const float z = bf2f(gz[vt][r]); Yb[mo * 1024u + (unsigned)tt + 16u * vt] = (bf16)f2bf(ov[vt][r] * rstd * gnv[vt] * z * sigmoidf_(z)); } }
            }
        }
#pragma unroll
        for (int kt = 0; kt < 4; ++kt)
#pragma unroll
            for (int vt = 0; vt < 4; ++vt) { f32x4 s = S[kt][vt]; s[0] *= Aend[kt][0]; s[1] *= Aend[kt][1]; s[2] *= Aend[kt][2]; s[3] *= Aend[kt][3];
                S[kt][vt] = __builtin_amdgcn_mfma_f32_16x16x16bf16_1k(Kb[kt], Vb[vt], s, 0, 0, 0); }
        cur = nxt;
    }
    if (MAIN) {
        if (!lat) { float* so = OUTP + (mixer ? OUT_SHG : OUT_SGLA) + ((size_t)(((seg * 2 + l) * 2 + dir) * 4 + head) * 64) * 64;
#pragma unroll
            for (int kt = 0; kt < 4; ++kt)
#pragma unroll
                for (int r = 0; r < 4; ++r) { unsigned o = soff0 + (unsigned)((16 * kt + r) * 64); asm volatile("" : "+v"(o) :: "memory");
#pragma unroll
                    for (int vt = 0; vt < 4; ++vt) so[o + 16 * vt] = S[kt][vt][r]; } }
    } else {
        __syncthreads();
        LAS float* SP = (LAS float*)C.lds + C.wave * 4096; LAS float* DP = (LAS float*)C.lds + 8 * 4096 + C.wave * 64;
#pragma unroll
        for (int kt = 0; kt < 4; ++kt)
#pragma unroll
            for (int r = 0; r < 4; ++r)
#pragma unroll
                for (int vt = 0; vt < 4; ++vt) SP[soff0 + (16 * kt + r) * 64 + 16 * vt] = S[kt][vt][r];
        if (tt == 0) {
#pragma unroll
            for (int i = 0; i < 4; ++i) *(LAS f32x4*)(DP + 16 * i + 4 * g) = (f32x4){dtot[i][0], dtot[i][1], dtot[i][2], dtot[i][3]}; }
        __syncthreads();
        const int segl = seg - 32;
        const LAS float* SA = (const LAS float*)C.lds; const LAS float* DA = SA + 8 * 4096;
#pragma unroll 1
        for (int it = 0; it < 16; ++it) { const int e = C.tid + 512 * it, d = e >> 12, kv = e & 4095, k = kv >> 6;
            float sv = SA[(4 * d + 0) * 4096 + kv];
#pragma unroll
            for (int q = 1; q < 4; ++q) sv = sv * DA[(4 * d + q) * 64 + k] + SA[(4 * d + q) * 4096 + kv];
            ((float*)(WSP + WS_GS))[((size_t)(((segl * 2 + mixer) * 4 + head) * 2 + d) * 64) * 64 + kv] = sv; }
        if (C.tid < 128) { const int d = C.tid >> 6, k = C.tid & 63;
            ((float*)(WSP + WS_GD))[(size_t)(((segl * 2 + mixer) * 4 + head) * 2 + d) * 64 + k] = (DA[(4 * d) * 64 + k] * DA[(4 * d + 1) * 64 + k]) * (DA[(4 * d + 2) * 64 + k] * DA[(4 * d + 3) * 64 + k]); }
    }
    __syncthreads();
}
__device__ __forceinline__ int PIX(int i) { return i + ((i >> 6) << 3); }
__device__ __forceinline__ f32x2 cmul(f32x2 a, f32x2 b) { return (f32x2){a.x * b.x - a.y * b.y, a.x * b.y + a.y * b.x}; }
__device__ __forceinline__ f32x2 cmulc(f32x2 a, f32x2 b) { return (f32x2){a.x * b.x + a.y * b.y, a.y * b.x - a.x * b.y}; }
template <bool INV> __device__ __forceinline__ f32x2 crot(f32x2 a) { return INV ? (f32x2){-a.y, a.x} : (f32x2){a.y, -a.x}; }
template <bool INV> __device__ __forceinline__ void dft8(f32x2 (&x)[8]) {
    const float h = 0.70710678118654752f;
    const f32x2 a0 = x[0] + x[4], a1 = x[0] - x[4], a2 = x[2] + x[6], a3 = crot<INV>(x[2] - x[6]);
    const f32x2 e0 = a0 + a2, e2 = a0 - a2, e1 = a1 + a3, e3 = a1 - a3;
    const f32x2 c0 = x[1] + x[5], c1 = x[1] - x[5], c2 = x[3] + x[7], c3 = crot<INV>(x[3] - x[7]);
    const f32x2 o0 = c0 + c2, o2r = c0 - c2, o1r = c1 + c3, o3r = c1 - c3;
    const f32x2 o1 = INV ? (f32x2){(o1r.x - o1r.y) * h, (o1r.y + o1r.x) * h} : (f32x2){(o1r.x + o1r.y) * h, (o1r.y - o1r.x) * h};
    const f32x2 o3 = INV ? (f32x2){-(o3r.x + o3r.y) * h, (o3r.x - o3r.y) * h} : (f32x2){(o3r.y - o3r.x) * h, -(o3r.x + o3r.y) * h};
    const f32x2 o2 = crot<INV>(o2r);
    x[0] = e0 + o0; x[1] = e1 + o1; x[2] = e2 + o2; x[3] = e3 + o3; x[4] = e0 - o0; x[5] = e1 - o1; x[6] = e2 - o2; x[7] = e3 - o3;
}
template <bool INV> __device__ __forceinline__ void dft16(f32x2 (&x)[16]) {
    f32x2 E[8], O[8];
#pragma unroll
    for (int k = 0; k < 8; ++k) { E[k] = x[2 * k]; O[k] = x[2 * k + 1]; }
    dft8<INV>(E); dft8<INV>(O);
    const float cs[8] = {1.f, 0.92387953251128674f, 0.70710678118654752f, 0.38268343236508977f, 0.f, -0.38268343236508977f, -0.70710678118654752f, -0.92387953251128674f};
    const float sn[8] = {0.f, 0.38268343236508977f, 0.70710678118654752f, 0.92387953251128674f, 1.f, 0.92387953251128674f, 0.70710678118654752f, 0.38268343236508977f};
#pragma unroll
    for (int k = 0; k < 8; ++k) { const f32x2 w = (f32x2){cs[k], INV ? sn[k] : -sn[k]}; const f32x2 o = cmul(O[k], w); x[k] = E[k] + o; x[k + 8] = E[k] - o; }
}
template <bool INV, int NC> __device__ __forceinline__ void fft_pass8(LAS f32x2* X, int tid) {
    constexpr int Q = NC / 8, ST = (NC == 512) ? 72 : Q;
#pragma unroll 1
    for (int rep = 0; rep < 2; ++rep) { const int b = tid + 512 * rep, blk = b / Q, pos = b % Q, base = blk * NC + pos;
        LAS f32x2* Xb = X + PIX(base);
        f32x2 v[8];
#pragma unroll
        for (int q = 0; q < 8; ++q) v[q] = Xb[q * ST];
        f32x2 w1 = (f32x2){1.f, 0.f};
        if (NC > 8) { float s, c; sincospif((float)pos * (2.f / NC), &s, &c); w1 = (f32x2){c, -s}; }
        if (!INV) { dft8<false>(v);
            if (NC > 8) { f32x2 w = w1;
#pragma unroll
                for (int r = 1; r < 8; ++r) { v[r] = cmul(v[r], w); w = cmul(w, w1); } } }
        else { if (NC > 8) { f32x2 w = w1;
#pragma unroll
                for (int r = 1; r < 8; ++r) { v[r] = cmulc(v[r], w); w = cmul(w, w1); } }
            dft8<true>(v); }
#pragma unroll
        for (int q = 0; q < 8; ++q) Xb[q * ST] = v[q]; }
    __syncthreads();
}
template <bool INV> __device__ __forceinline__ void fft_pass16(LAS f32x2* X, int tid) {
    f32x2 v[16]; LAS f32x2* Xb = X + PIX(tid);
#pragma unroll
    for (int q = 0; q < 16; ++q) v[q] = Xb[576 * q];
    float s, c; sincospif((float)tid * (1.f / 4096.f), &s, &c); const f32x2 w1 = (f32x2){c, -s};
    if (!INV) { dft16<false>(v); f32x2 w = w1;
#pragma unroll
        for (int r = 1; r < 16; ++r) { v[r] = cmul(v[r], w); w = cmul(w, w1); } }
    else { f32x2 w = w1;
#pragma unroll
        for (int r = 1; r < 16; ++r) { v[r] = cmulc(v[r], w); w = cmul(w, w1); }
        dft16<true>(v); }
#pragma unroll
    for (int q = 0; q < 16; ++q) Xb[576 * q] = v[q];
    __syncthreads();
}
__device__ __forceinline__ void fft_fwd(LAS f32x2* x, int tid, bool lat) { if (lat) fft_pass16<false>(x, tid); fft_pass8<false, 512>(x, tid); fft_pass8<false, 64>(x, tid); fft_pass8<false, 8>(x, tid); }
__device__ __forceinline__ void fft_inv(LAS f32x2* x, int tid, bool lat) { fft_pass8<true, 8>(x, tid); fft_pass8<true, 64>(x, tid); fft_pass8<true, 512>(x, tid); if (lat) fft_pass16<true>(x, tid); }
template <int ORDER>
__device__ __forceinline__ void hy_unit(const Ctx& C, int l, int stream, int c) {
    LAS f32x2* x = (LAS f32x2*)C.lds; LAS v2u* ZG = (LAS v2u*)(x + 9216);
    const int f = ORDER * 256 + c; const bool lat = stream != 0;
    const int slen = stream ? 4096 : 256;
    const int zc = c, gc = (ORDER + 1) * 256 + c;
    __syncthreads();
    {   int tid = C.tid; asm volatile("" : "+v"(tid));
        LAS f32x2* xt = x + PIX(tid);
        if (stream) { const float* h = (const float*)(WSP + WS_HT) + ((size_t)l * 512 + f) * 4096;
#pragma unroll
            for (int i = 0; i < 8; ++i) { xt[576 * i] = (f32x2){h[(unsigned)(tid + 512 * i)], 0.f}; xt[576 * (i + 8)] = (f32x2){0.f, 0.f}; } }
        else { const float* h = (const float*)(WSP + WS_HTC) + ((size_t)l * 512 + f) * 256; const float hv = tid < 256 ? h[(unsigned)tid] : 0.f;
#pragma unroll
            for (int i = 0; i < 16; ++i) xt[576 * i] = (f32x2){hv, 0.f}; }
    }
    __syncthreads();
    fft_fwd(x, C.tid, lat);
    f32x2 H[16];
    {   LAS f32x2* xt = x + PIX(C.tid);
#pragma unroll
        for (int i = 0; i < 16; ++i) H[i] = xt[576 * i]; }
    __syncthreads();
    {   int tid = C.tid; asm volatile("" : "+v"(tid));
        LAS f32x2* xt = x + PIX(tid);
        const float* cw = INP(I_HYCW) + (size_t)l * 3 * 768; const float* cbp = INP(I_HYCB) + (size_t)l * 768;
        const float zw0 = cw[zc], zw1 = cw[768 + zc], zw2 = cw[1536 + zc], zb = cbp[zc];
        const float gw0 = cw[gc], gw1 = cw[768 + gc], gw2 = cw[1536 + gc], gb = cbp[gc];
        const bf16* CTv = (const bf16*)(WSP + WS_CT) + ((size_t)(c * 2 + stream) * 2) * 8192;
        const float* Z1 = (const float*)(WSP + WS_CT) + (size_t)c * 16384;
        const bool tval = stream ? true : (tid < 256);
#pragma unroll
        for (int i = 0; i < 16; ++i) {
            const bool valid = stream ? (i < 8) : tval;
            float zr = 0.f, zi = 0.f;
            if (valid) {
                const int pos = stream ? tid + 512 * i : tid;
                const unsigned mre = stream ? MCTX + pos : (2 * i) * 256 + pos, mim = mre + slen;
                const bool hasl = pos > 0, hasr = pos + 1 < slen;
                if (ORDER == 0) {
                    const bf16* v0 = CTv + (mre & 8191u); const bf16* v1 = CTv + (mim & 8191u);
                    zr = zb + zw1 * bf2f(v0[0]) + (hasl ? zw0 * bf2f(v0[-1]) : 0.f) + (hasr ? zw2 * bf2f(v0[1]) : 0.f);
                    zi = zb + zw1 * bf2f(v1[0]) + (hasl ? zw0 * bf2f(v1[-1]) : 0.f) + (hasr ? zw2 * bf2f(v1[1]) : 0.f);
                    const bf16* g0 = v0 + 8192; const bf16* g1 = v1 + 8192;
                    const float gr = gb + gw1 * bf2f(g0[0]) + (hasl ? gw0 * bf2f(g0[-1]) : 0.f) + (hasr ? gw2 * bf2f(g0[1]) : 0.f);
                    const float gi = gb + gw1 * bf2f(g1[0]) + (hasl ? gw0 * bf2f(g1[-1]) : 0.f) + (hasr ? gw2 * bf2f(g1[1]) : 0.f);
                    ZG[tid + 512 * i] = (v2u){pk2(zr, zi), pk2(gr, gi)};
                } else { zr = Z1[mre]; zi = Z1[mim]; }
            }
            xt[576 * i] = (f32x2){zr, zi};
        }
    }
    __syncthreads();
    fft_fwd(x, C.tid, lat);
    {   LAS f32x2* xt = x + PIX(C.tid);
#pragma unroll
        for (int i = 0; i < 16; ++i) { const f32x2 a = xt[576 * i]; xt[576 * i] = cmul(a, H[i]); } }
    __syncthreads();
    fft_inv(x, C.tid, lat);
    {   int tid2 = C.tid; asm volatile("" : "+v"(tid2));
        const float skip = INP(I_HYSKIP)[l * 512 + f];
        const float scale = stream ? (1.f / 8192.f) : (1.f / 512.f);
        const bool tval2 = stream ? true : (tid2 < 256);
        bf16* Yb = (bf16*)(WSP + WS_XN) + 512 + c; float* Z1 = (float*)(WSP + WS_CT) + (size_t)c * 16384;
        const bf16* CT2 = (const bf16*)(WSP + WS_CT2) + (size_t)c * 16384;
        const float* cw = INP(I_HYCW) + (size_t)l * 3 * 768; const float gw0 = cw[gc], gw1 = cw[768 + gc], gw2 = cw[1536 + gc], gb = INP(I_HYCB)[(size_t)l * 768 + gc];
        const LAS f32x2* xo = x + PIX(tid2) + (stream ? 2304 : 144);
#pragma unroll
        for (int i = 0; i < 16; ++i) {
            const bool valid = stream ? (i < 8) : tval2;
            if (valid) {
                const int pos = stream ? tid2 + 512 * i : tid2;
                const unsigned mre = stream ? MCTX + pos : (2 * i) * 256 + pos, mim = mre + slen;
                const f32x2 y = xo[576 * i];
                float zr, zi, gr, gi;
                if (ORDER == 0) { const v2u zz = ZG[tid2 + 512 * i]; zr = bflo(zz.x); zi = bfhi(zz.x); gr = bflo(zz.y); gi = bfhi(zz.y); }
                else { zr = Z1[mre]; zi = Z1[mim]; const bool hasl = pos > 0, hasr = pos + 1 < slen; const bf16* g0 = CT2 + mre; const bf16* g1 = CT2 + mim;
                    gr = gb + gw1 * bf2f(g0[0]) + (hasl ? gw0 * bf2f(g0[-1]) : 0.f) + (hasr ? gw2 * bf2f(g0[1]) : 0.f);
                    gi = gb + gw1 * bf2f(g1[0]) + (hasl ? gw0 * bf2f(g1[-1]) : 0.f) + (hasr ? gw2 * bf2f(g1[1]) : 0.f); }
                const float ore = gr * (y.x * scale + skip * zr), oim = gi * (y.y * scale + skip * zi);
                if (ORDER == 0) { Z1[mre] = ore; Z1[mim] = oim; }
                else { Yb[mre * 1024u] = (bf16)f2bf(ore); Yb[mim * 1024u] = (bf16)f2bf(oim); }
            }
        }
    }
    __syncthreads();
}
__device__ __forceinline__ void mixers_pass1(const Ctx& C, int l) {
    for (int rep = 0; rep < REP_RG; ++rep)
    for (int u = C.vcu; u < 256; u += C.G) rg_main(C, l, u);
    __syncthreads();
    for (int u = C.vcu; u < 256; u += C.G) { hy_unit<0>(C, l, 1, u); hy_unit<0>(C, l, 0, u); }
    for (int u = C.vcu; u < 256; u += C.G) { if (u & 4) gla3_unit<false, 1>(C, l, 32 + (u >> 3), u & 3); else gla3_unit<false, 0>(C, l, 32 + (u >> 3), u & 3); }
}
__device__ __forceinline__ void mixers_pass2(const Ctx& C, int l) {
    for (int u = C.vcu; u < 128; u += C.G) { if (u & 1) gla3_unit<true, 1>(C, l, u >> 1, 0); else gla3_unit<true, 0>(C, l, u >> 1, 0); }
    __syncthreads();
    for (int rep = 0; rep < REP_HY; ++rep)
    for (int u = C.vcu; u < 256; u += C.G) { hy_unit<1>(C, l, 1, u); hy_unit<1>(C, l, 0, u); }
    for (int u = C.vcu; u < 128; u += C.G) rg_corr(C, l, u);
}
#ifndef PROBE_MASK
#define PROBE_MASK 0u
#endif
#define PH_T0(k) do { if ((PROBE_MASK >> (k)) & 1u) tph = __builtin_amdgcn_s_memrealtime(); } while (0)
#define PH_T1(k) do { if ((PROBE_MASK >> (k)) & 1u) tacc += __builtin_amdgcn_s_memrealtime() - tph; } while (0)
template <int l>
__device__ __forceinline__ void layer_phases(LAS unsigned char* ldsb, const int lo, const int hi, const XcdBarrier& bar, unsigned long long& tacc) {
    unsigned long long tph = 0;
#define IN(k) (lo <= (k) && (k) < hi)
#define SEAM(k) do { if (IN((k) + 1)) xcd_barrier(bar); } while (0)
    float* const modp = (float*)(WSP + WS_MOD);
    bf16* const XN = (bf16*)(WSP + WS_XN); bf16* const PROJ = (bf16*)(WSP + WS_PROJ);
        constexpr int pb = (l == 0) ? 2 : 10;
        const float* modl = modp + (size_t)l * 3 * 6144;
        if (IN(pb + 0)) {
            PH_T0(pb + 0);
            const Ctx C = make_ctx(ldsb);
            pg8::Gemm g{XN, (const bf16*)(WSP + WS_WIN), M, NIN, D}; pg8::StaticOrder S; S.init(M, NIN, C.G, (int)blockIdx.x);
            pg8::EpiProj E{PROJ, (bf16*)(WSP + WS_CT), (bf16*)(WSP + WS_CT2)};
            for (int rep = 0; rep < REP_GIN; ++rep)
            pg8::gemm_phase<pg8::EpiProj, pg8::StaticOrder, true, true>(C.lds, g, S, E);
            SEAM(pb + 0); PH_T1(pb + 0);
        }
        if (IN(pb + 1)) { PH_T0(pb + 1); const Ctx C = make_ctx(ldsb); mixers_pass1(C, l); SEAM(pb + 1); PH_T1(pb + 1); }
        if (IN(pb + 2)) { PH_T0(pb + 2); const Ctx C = make_ctx(ldsb); mixers_pass2(C, l); SEAM(pb + 2); PH_T1(pb + 2); }
        if (IN(pb + 3)) {
            PH_T0(pb + 3);
            const Ctx C = make_ctx(ldsb);
            pg8::Gemm g{XN, (const bf16*)(WSP + WS_WOUT), M, D, D}; pg8::StaticOrder S; S.init(M, D, C.G, (int)blockIdx.x);
            pg8::EpiResid E{OUTP, modl + 2048};
            pg8::gemm_phase<pg8::EpiResid, pg8::StaticOrder, true, true>(C.lds, g, S, E);
            SEAM(pb + 3); PH_T1(pb + 3);
        }
        if (IN(pb + 4)) { PH_T0(pb + 4); const Ctx C = make_ctx(ldsb); for (int rep = 0; rep < REP_NORM; ++rep) norm_rows<false>(C, INP(I_N2G) + l * D, modl, 3072, 4096); SEAM(pb + 4); PH_T1(pb + 4); }
        if (IN(pb + 5)) {
            PH_T0(pb + 5);
            const Ctx C = make_ctx(ldsb);
            pg8::Gemm g{XN, (const bf16*)(WSP + WS_W13), M, 2 * DFF, D}; pg8::StaticOrder S; S.init(M, 2 * DFF, C.G, (int)blockIdx.x);
            pg8::EpiSwiGLU E{PROJ, DFF};
            for (int rep = 0; rep < REP_GUP; ++rep)
            pg8::gemm_phase<pg8::EpiSwiGLU, pg8::StaticOrder, true, true>(C.lds, g, S, E);
            SEAM(pb + 5); PH_T1(pb + 5);
        }
        if (IN(pb + 6)) {
            PH_T0(pb + 6);
            const Ctx C = make_ctx(ldsb);
            pg8::Gemm g{PROJ, (const bf16*)(WSP + WS_W2), M, D, DFF}; pg8::StaticOrder S; S.init(M, D, C.G, (int)blockIdx.x);
            pg8::EpiResid E{OUTP, modl + 5120};
            pg8::gemm_phase<pg8::EpiResid, pg8::StaticOrder, true, true>(C.lds, g, S, E);
            SEAM(pb + 6); PH_T1(pb + 6);
        }
        if (l == 0 && IN(9)) { PH_T0(9); const Ctx C = make_ctx(ldsb); convert_weights(C, 1); norm_rows<false>(C, INP(I_N1G) + D, modp + 3 * 6144, 0, 1024); SEAM(9); PH_T1(9); }
#undef IN
#undef SEAM
}
struct Args { const float* in[N_IN]; float* out; unsigned char* ws; int ph_lo, ph_hi; };
constexpr int N_PHASES = 18;
__global__ void __launch_bounds__(NWAVES * 64, 2) mk_fwd(Args args) {
    extern __shared__ __attribute__((aligned(16))) unsigned char lds_raw[];
    LAS unsigned char* const ldsb = (LAS unsigned char*)lds_raw;
    volatile LAS unsigned* MISC = (volatile LAS unsigned*)(ldsb + MISC_OFF);
    for (int u = threadIdx.x; u < (LDS_BYTES - LDSCTL_OFF) / 4; u += NWAVES * 64) ((LAS unsigned*)(ldsb + LDSCTL_OFF))[u] = 0u;
    __syncthreads();
    const int lo = args.ph_lo, hi = args.ph_hi;
    const bool use_bar = (hi - lo) > 1;
    XcdBarrier bar; bar.bar = (unsigned*)(WSP + WS_CTL) + CW_BAR; bar.x = 0; bar.st = nullptr;
    if (use_bar) bar = xcd_barrier_post((unsigned*)(WSP + WS_CTL) + CW_BAR, MISC + 8);
#define IN(k) (lo <= (k) && (k) < hi)
#define SEAM(k) do { if (IN((k) + 1)) xcd_barrier(bar); } while (0)
    float* const modp = (float*)(WSP + WS_MOD);
    bf16* const XN = (bf16*)(WSP + WS_XN); bf16* const PROJ = (bf16*)(WSP + WS_PROJ);

    unsigned long long tacc = 0, tph = 0;
    if (IN(0)) { PH_T0(0); const Ctx C = make_ctx(ldsb); for (int rep = 0; rep < REP_P0; ++rep) { p0_prologue(C); __syncthreads(); } SEAM(0); PH_T1(0); }
    if (IN(1)) { PH_T0(1); const Ctx C = make_ctx(ldsb); for (int rep = 0; rep < REP_P1; ++rep) { norm_rows<true>(C, INP(I_N1G), modp, 0, 1024); hyena_filters(C); __syncthreads(); } SEAM(1); PH_T1(1); }
    layer_phases<0>(ldsb, lo, hi, bar, tacc);
    layer_phases<1>(ldsb, lo, hi, bar, tacc);
    if (IN(17)) { PH_T0(17); const Ctx C = make_ctx(ldsb); final_norm(C); PH_T1(17); }
    if (PROBE_MASK != 0u && blockIdx.x == 0) { const unsigned long long te = __builtin_amdgcn_s_memrealtime(); while (__builtin_amdgcn_s_memrealtime() - te < tacc) __builtin_amdgcn_s_sleep(8); }
#undef IN
#undef SEAM
}

#ifndef MK_N_LAUNCHES
#define MK_N_LAUNCHES 1
#endif
extern "C" void kernel_launch(void* const* d_in, const int* in_sizes, int n_in, void* d_out, int out_size, void* d_ws, size_t ws_size, hipStream_t stream) {
    static int grid = 0;
    if (grid == 0) {
        if (n_in != N_IN || out_size != (int)OUT_END || ws_size < WS_END) { fprintf(stderr, "kernel_launch: unexpected sizes n_in %d out %d ws %zu\n", n_in, out_size, ws_size); grid = -1; return; }
        int dev = 0, cus = 0, per_cu = 0;
        if (hipGetDevice(&dev) != hipSuccess || hipDeviceGetAttribute(&cus, hipDeviceAttributeMultiprocessorCount, dev) != hipSuccess) { grid = -1; return; }
        if (hipFuncSetAttribute((const void*)mk_fwd, hipFuncAttributeMaxDynamicSharedMemorySize, LDS_BYTES) != hipSuccess) { fprintf(stderr, "kernel_launch: hipFuncSetAttribute failed\n"); grid = -1; return; }
        if (hipOccupancyMaxActiveBlocksPerMultiprocessor(&per_cu, (const void*)mk_fwd, NWAVES * 64, LDS_BYTES) != hipSuccess || per_cu < 1) { fprintf(stderr, "kernel_launch: occupancy query says %d blocks per CU\n", per_cu); per_cu = 1; }
        (void)hipGetLastError();
        grid = cus;
    }
    if (grid < 0) return;
    if (hipMemsetAsync((char*)d_ws + WS_CTL, 0, CTL_ZERO_BYTES, stream) != hipSuccess) { fprintf(stderr, "kernel_launch: memset failed\n"); return; }
    Args a{};
    for (int i = 0; i < N_IN; ++i) a.in[i] = (const float*)d_in[i];
    a.out = (float*)d_out; a.ws = (unsigned char*)d_ws;
#if MK_N_LAUNCHES == 1
    a.ph_lo = 0; a.ph_hi = N_PHASES;
    hipLaunchKernelGGL(mk_fwd, dim3(grid), dim3(NWAVES * 64), LDS_BYTES, stream, a);
#else
    for (int p = 0; p < N_PHASES; ++p) { a.ph_lo = p; a.ph_hi = p + 1; hipLaunchKernelGGL(mk_fwd, dim3(grid), dim3(NWAVES * 64), LDS_BYTES, stream, a); }
#endif
    const hipError_t le = hipPeekAtLastError();
    if (le != hipSuccess) fprintf(stderr, "kernel_launch: launch failed: %s\n", hipGetErrorName(le));
}
```

```cpp
#include <hip/hip_runtime.h>
#include <cstdio>
#include <cstdint>
#include <cmath>
namespace pg8 {
#define PG8_LAS __attribute__((address_space(3)))
typedef unsigned short bf16_t;
typedef short bf16x8 __attribute__((ext_vector_type(8)));
typedef float f32x4 __attribute__((ext_vector_type(4)));
typedef unsigned u32x4 __attribute__((ext_vector_type(4)));
constexpr int BM = 256, BK = 64, HALF = 128, HTB = HALF * BK * 2  , STAGE_BYTES = 8 * HTB, NXCD = 8, WGM = 8;

__host__ __device__ __forceinline__ int lds_byte(int r, int c) { const int st = (r >> 4) * 2 + (c >> 5), rr = r & 15, cc = c & 31, ob = rr * 64 + cc * 2; return st * 1024 + (ob ^ (((ob >> 9) & 1) << 5)); }
__host__ __device__ __forceinline__ void stage_rc(int b, int& R, int& C) { const int st = b / 1024, sb = b % 1024, swz = sb ^ (((sb >> 9) & 1) << 5); R = (st >> 1) * 16 + swz / 64; C = (st & 1) * 32 + (swz % 64) / 2; }
__host__ __device__ __forceinline__ int perm32(int rho) { const int n = rho >> 4, i = rho & 15; return 8 * (i >> 2) + 4 * n + (i & 3); }

struct Unit { int pm, pn; };
struct Gemm { const bf16_t* A; const bf16_t* Bt; int M, N, K; };

struct StaticOrder {
    int nM, nN, nwg, G, c;
    __host__ __device__ void init(int M, int N, int G_, int c_) { nM = M / BM; nN = N / BM; nwg = nM * nN; G = G_; c = c_; }
    __host__ __device__ bool next(int i, Unit& u) const {
        const long L = (long)i * G + c; if (L >= nwg) return false;
        int wgid = (int)L; { const int q = nwg / NXCD, r = nwg % NXCD, xcd = wgid % NXCD, off = wgid / NXCD; wgid = (xcd < r ? xcd * (q + 1) : r * (q + 1) + (xcd - r) * q) + off; }
        const int nig = WGM * nN, gid = wgid / nig, fm = gid * WGM, gsz = (nM - fm) < WGM ? (nM - fm) : WGM;
        u.pm = fm + ((wgid % nig) % gsz); u.pn = (wgid % nig) / gsz; return true;
    }
    __device__ __forceinline__ void a_ready(const Unit&) const {}
    __device__ __forceinline__ void done(const Unit&) const {}
};
__device__ __forceinline__ unsigned cvt_pk_bf16(float lo, float hi) { unsigned r; asm volatile("v_cvt_pk_bf16_f32 %0, %1, %2" : "=v"(r) : "v"(lo), "v"(hi)); return r; }
typedef float f32x2 __attribute__((ext_vector_type(2)));
constexpr int PROJ_LD = 2848;
struct EpiProj {
    static constexpr bool PERM = true, AFTER_DRAIN = false;
    bf16_t* PROJ; bf16_t* CT; bf16_t* CT2;
    __device__ __forceinline__ void operator()(const f32x4 (&acc)[2][2][4][2], const Unit& u, int wr, int wc, int fr, int fq) const {
        const int row0 = u.pm * BM + wr * 64 + fr;
        if (u.pn >= 3) {
            const bool lrt = (u.pn == 14);
            if (lrt && !(wc == 0 && fq < 2)) return;
            const unsigned voff0 = (unsigned)row0 * (unsigned)PROJ_LD + (unsigned)((u.pn - 3) * 256 + wc * 32 + 8 * fq);
#pragma unroll
            for (int ai = 0; ai < 2; ++ai)
#pragma unroll
                for (int m = 0; m < 4; ++m) { unsigned voff = voff0 + (unsigned)((ai * HALF + m * 16) * PROJ_LD); asm volatile("" : "+v"(voff));
#pragma unroll
                    for (int bj = 0; bj < 2; ++bj) { if (lrt && bj == 1) continue;
                        const f32x4 v0 = acc[ai][bj][m][0], v1 = acc[ai][bj][m][1];
                        u32x4 w; w.x = cvt_pk_bf16(v0[0], v0[1]); w.y = cvt_pk_bf16(v0[2], v0[3]); w.z = cvt_pk_bf16(v1[0], v1[1]); w.w = cvt_pk_bf16(v1[2], v1[3]);
                        *(u32x4*)(PROJ + voff + bj * HALF) = w; } }
        } else {
            bf16_t* base = (u.pn == 0) ? CT : (u.pn == 1) ? CT + 8192 : CT2;
            const unsigned cs = (u.pn == 2) ? 16384u : 32768u;
            const unsigned rofs = (u.pn == 2) ? (unsigned)row0 : ((unsigned)(row0 & 8191) + ((row0 >> 13) ? 16384u : 0u));
            const unsigned voff0 = (unsigned)(wc * 32 + 8 * fq) * cs + rofs;
#pragma unroll
            for (int bj = 0; bj < 2; ++bj)
#pragma unroll
                for (int n = 0; n < 2; ++n)
#pragma unroll
                    for (int e = 0; e < 4; e += 2) { unsigned voff = voff0 + (unsigned)(bj * HALF + 4 * n + e) * cs; asm volatile("" : "+v"(voff)); unsigned voff1 = voff + cs; asm volatile("" : "+v"(voff1));
#pragma unroll
                        for (int ai = 0; ai < 2; ++ai)
#pragma unroll
                            for (int m = 0; m < 4; ++m) { const unsigned w = cvt_pk_bf16(acc[ai][bj][m][n][e], acc[ai][bj][m][n][e + 1]);
                                base[voff + ai * HALF + m * 16] = (bf16_t)(w & 0xffffu); base[voff1 + ai * HALF + m * 16] = (bf16_t)(w >> 16); }
                        asm volatile("" ::: "memory"); }
        }
    }
};
struct EpiResid {
    static constexpr bool PERM = false, AFTER_DRAIN = false;
    float* X; const float* gate3;
    __device__ __forceinline__ void operator()(const f32x4 (&acc)[2][2][4][2], const Unit& u, int wr, int wc, int fr, int fq) const {
        const int r = (u.pm < 32) ? 0 : 1 + ((u.pm - 32) >> 4);
        const float* g = gate3 + r * 6144;
        const int col0 = u.pn * BM + wc * 32 + 4 * fq;
        f32x4 gv[2][2];
#pragma unroll
        for (int bj = 0; bj < 2; ++bj)
#pragma unroll
            for (int n = 0; n < 2; ++n) gv[bj][n] = *(const f32x4*)(g + col0 + bj * HALF + n * 16);
#pragma unroll
        for (int ai = 0; ai < 2; ++ai)
#pragma unroll
            for (int m = 0; m < 4; ++m) { float* rowp = X + (size_t)(u.pm * BM + ai * HALF + wr * 64 + m * 16 + fr) * 1024 + col0;
#pragma unroll
                for (int bj = 0; bj < 2; ++bj)
#pragma unroll
                    for (int n = 0; n < 2; ++n) { f32x4* p = (f32x4*)(rowp + bj * HALF + n * 16); const f32x4 x = *p; *p = x + gv[bj][n] * acc[ai][bj][m][n]; } }
    }
};
struct EpiSwiGLU {
    static constexpr bool PERM = true, AFTER_DRAIN = false;
    bf16_t* HID; int ldh;
    __device__ __forceinline__ void operator()(const f32x4 (&acc)[2][2][4][2], const Unit& u, int wr, int wc, int fr, int fq) const {
        const int row0 = u.pm * BM + wr * 64 + fr, col0 = u.pn * HALF + wc * 32 + 8 * fq;
#pragma unroll
        for (int ai = 0; ai < 2; ++ai)
#pragma unroll
            for (int m = 0; m < 4; ++m) { float h[8];
#pragma unroll
                for (int n = 0; n < 2; ++n)
#pragma unroll
                    for (int e = 0; e < 4; ++e) { const float a = acc[ai][0][m][n][e], b = acc[ai][1][m][n][e]; h[4 * n + e] = a * b * __builtin_amdgcn_rcpf(1.f + __expf(-a)); }
                u32x4 w; w.x = cvt_pk_bf16(h[0], h[1]); w.y = cvt_pk_bf16(h[2], h[3]); w.z = cvt_pk_bf16(h[4], h[5]); w.w = cvt_pk_bf16(h[6], h[7]);
                *(u32x4*)(HID + (size_t)(row0 + ai * HALF + m * 16) * ldh + col0) = w; }
    }
};
template <class Epi, class Sched, bool ALIGN_EPI = false, bool SP2 = false>
__device__ __forceinline__ void gemm_phase(PG8_LAS unsigned char* lds, const Gemm g, const Sched& S, const Epi& E) {
    const int tid = threadIdx.x, wid = __builtin_amdgcn_readfirstlane(tid >> 6), lane = tid & 63, wr = wid >> 2, wc = wid & 3, fr = lane & 15, fq = lane >> 4;
    const int K = g.K, nt = K / BK;
    unsigned voffA[2], voffB[2];
#pragma unroll
    for (int i = 0; i < 2; ++i) { int R, C; stage_rc(tid * 16 + i * 8192, R, C); const int Rb = Epi::PERM ? ((R & ~31) + perm32(R & 31)) : R;
        voffA[i] = (unsigned)(R * K + C) * 2u; voffB[i] = (unsigned)(Rb * K + C) * 2u; }
    const size_t kstep = (size_t)(BK * 2);
    const size_t hstep = (size_t)HALF * K * 2;
    const size_t tstep = 2 * hstep;
    const unsigned ldsw = (unsigned)wid * 1024u;
    const int aoff = lds_byte(wr * 64 + fr, fq * 8), boff = lds_byte(wc * 32 + fr, fq * 8);
#define PG8_SA(b, h) (((b) * 2 + (h)) * HTB)
#define PG8_SB(b, h) ((4 + (b) * 2 + (h)) * HTB)
#define PG8_STAGE(bufoff, gbase, voff) do { _Pragma("unroll") for (int _i = 0; _i < 2; ++_i) \
        __builtin_amdgcn_global_load_lds((const unsigned*)((const char*)(gbase) + (voff)[_i]), (PG8_LAS unsigned*)(lds + (bufoff) + ldsw + _i * 8192), 16, 0, 0); } while (0)
#define PG8_LDA(dst, b, h) do { _Pragma("unroll") for (int m = 0; m < 4; ++m) _Pragma("unroll") for (int k = 0; k < 2; ++k) dst[m][k] = *(const PG8_LAS bf16x8*)(lds + PG8_SA(b, h) + aoff + m * 2048 + k * 1024); } while (0)
#define PG8_LDB(dst, b, h) do { _Pragma("unroll") for (int n = 0; n < 2; ++n) _Pragma("unroll") for (int k = 0; k < 2; ++k) dst[n][k] = *(const PG8_LAS bf16x8*)(lds + PG8_SB(b, h) + boff + n * 2048 + k * 1024); } while (0)
#define PG8_MMA(ai, bj, At, Bt) do { __builtin_amdgcn_s_setprio(1); _Pragma("unroll") for (int m = 0; m < 4; ++m) _Pragma("unroll") for (int n = 0; n < 2; ++n) _Pragma("unroll") for (int k = 0; k < 2; ++k) \
        acc[ai][bj][m][n] = __builtin_amdgcn_mfma_f32_16x16x32_bf16(Bt[n][k], At[m][k], acc[ai][bj][m][n], 0, 0, 0); __builtin_amdgcn_s_setprio(0); } while (0)
#define PG8_WAIT_V(n) asm volatile("s_waitcnt vmcnt(" #n ")" ::: "memory")
#define PG8_WAIT_L(n) asm volatile("s_waitcnt lgkmcnt(" #n ")" ::: "memory")
#define PG8_BAR __builtin_amdgcn_s_barrier()
#define PG8_SCHED __builtin_amdgcn_sched_barrier(0)
    Unit cur, nxt; int ui = 0;
    if (!S.next(0, cur)) return;
    f32x4 acc[2][2][4][2];
#pragma unroll
    for (int a = 0; a < 2; ++a)
#pragma unroll
        for (int b = 0; b < 2; ++b)
#pragma unroll
            for (int m = 0; m < 4; ++m)
#pragma unroll
                for (int n = 0; n < 2; ++n) acc[a][b][m][n] = (f32x4){0.f, 0.f, 0.f, 0.f};
    bf16x8 At[4][2], B0[2][2], B1[2][2];
    const char* cA = (const char*)g.A + (size_t)cur.pm * tstep; const char* cB = (const char*)g.Bt + (size_t)cur.pn * tstep;
    S.a_ready(cur);
    if constexpr (SP2) {
        PG8_STAGE(PG8_SB(0, 0), cB, voffB); PG8_STAGE(PG8_SB(0, 1), cB + hstep, voffB); PG8_STAGE(PG8_SA(0, 0), cA, voffA); PG8_STAGE(PG8_SA(0, 1), cA + hstep, voffA);
        if (wr == 1) PG8_BAR;
        PG8_WAIT_V(2); PG8_BAR;
        PG8_STAGE(PG8_SB(1, 0), cB + kstep, voffB); PG8_STAGE(PG8_SA(1, 0), cA + kstep, voffA); PG8_STAGE(PG8_SB(1, 1), cB + hstep + kstep, voffB);
        PG8_WAIT_V(6); PG8_BAR;
    } else {
        PG8_STAGE(PG8_SB(0, 0), cB, voffB); PG8_STAGE(PG8_SA(0, 0), cA, voffA); PG8_STAGE(PG8_SB(0, 1), cB + hstep, voffB); PG8_STAGE(PG8_SA(0, 1), cA + hstep, voffA);
        if (wr == 1) PG8_BAR;
        PG8_WAIT_V(4); PG8_BAR;
        PG8_STAGE(PG8_SB(1, 0), cB + kstep, voffB); PG8_STAGE(PG8_SA(1, 0), cA + kstep, voffA); PG8_STAGE(PG8_SB(1, 1), cB + hstep + kstep, voffB);
        PG8_WAIT_V(6); PG8_BAR;
    }
    for (;;) {
        const bool has_next = S.next(ui + 1, nxt);
        const char* nA = has_next ? (const char*)g.A + (size_t)nxt.pm * tstep : cA; const char* nB = has_next ? (const char*)g.Bt + (size_t)nxt.pn * tstep : cB;
        for (int t = 0; t < nt; t += 2) {
            const bool last = (t == nt - 2);
            const char* a1 = cA + (size_t)(t + 1) * kstep;
            const char* a2 = last ? nA : cA + (size_t)(t + 2) * kstep; const char* b2 = last ? nB : cB + (size_t)(t + 2) * kstep;
            const char* a3 = a2 + kstep; const char* b3 = b2 + kstep;
            if (last && has_next) S.a_ready(nxt);
            if constexpr (SP2) {
            PG8_LDB(B0, 0, 0); PG8_LDB(B1, 0, 1); PG8_SCHED; PG8_LDA(At, 0, 0); PG8_STAGE(PG8_SA(1, 1), a1 + hstep, voffA);
            PG8_WAIT_V(8); PG8_WAIT_L(0); PG8_BAR; PG8_MMA(0, 0, At, B0); PG8_MMA(0, 1, At, B1); PG8_BAR; PG8_SCHED;
            PG8_LDA(At, 0, 1); PG8_STAGE(PG8_SB(0, 0), b2, voffB); PG8_STAGE(PG8_SB(0, 1), b2 + hstep, voffB); PG8_STAGE(PG8_SA(0, 0), a2, voffA);
            PG8_WAIT_V(8); PG8_WAIT_L(0); PG8_BAR; PG8_MMA(1, 0, At, B0); PG8_MMA(1, 1, At, B1); PG8_BAR; PG8_SCHED;
            PG8_LDB(B0, 1, 0); PG8_LDB(B1, 1, 1); PG8_SCHED; PG8_LDA(At, 1, 0); PG8_STAGE(PG8_SA(0, 1), a2 + hstep, voffA);
            PG8_WAIT_V(8); PG8_WAIT_L(0); PG8_BAR; PG8_MMA(0, 0, At, B0); PG8_MMA(0, 1, At, B1); PG8_BAR; PG8_SCHED;
            PG8_LDA(At, 1, 1); PG8_STAGE(PG8_SB(1, 0), b3, voffB); PG8_STAGE(PG8_SB(1, 1), b3 + hstep, voffB); PG8_STAGE(PG8_SA(1, 0), a3, voffA);
            PG8_WAIT_V(8); PG8_WAIT_L(0); PG8_BAR; PG8_MMA(1, 0, At, B0); PG8_MMA(1, 1, At, B1); PG8_BAR; PG8_SCHED;
            } else {
            PG8_LDB(B0, 0, 0); PG8_SCHED; PG8_LDA(At, 0, 0); PG8_STAGE(PG8_SA(1, 1), a1 + hstep, voffA);
            PG8_WAIT_L(8); PG8_BAR; PG8_WAIT_L(0); PG8_MMA(0, 0, At, B0); PG8_BAR; PG8_SCHED;
            PG8_LDB(B1, 0, 1); PG8_STAGE(PG8_SB(0, 0), b2, voffB);
            PG8_BAR; PG8_WAIT_L(0); PG8_MMA(0, 1, At, B1); PG8_BAR;
            PG8_LDA(At, 0, 1); PG8_STAGE(PG8_SA(0, 0), a2, voffA);
            PG8_BAR; PG8_WAIT_L(0); PG8_MMA(1, 0, At, B0); PG8_BAR; PG8_SCHED;
            PG8_STAGE(PG8_SB(0, 1), b2 + hstep, voffB);
            PG8_WAIT_V(6); PG8_BAR; PG8_MMA(1, 1, At, B1); PG8_BAR;
            PG8_LDB(B0, 1, 0); PG8_SCHED; PG8_LDA(At, 1, 0); PG8_STAGE(PG8_SA(0, 1), a2 + hstep, voffA);
            PG8_WAIT_L(8); PG8_BAR; PG8_WAIT_L(0); PG8_MMA(0, 0, At, B0); PG8_BAR; PG8_SCHED;
            PG8_LDB(B1, 1, 1); PG8_STAGE(PG8_SB(1, 0), b3, voffB);
            PG8_BAR; PG8_WAIT_L(0); PG8_MMA(0, 1, At, B1); PG8_BAR;
            PG8_LDA(At, 1, 1); PG8_STAGE(PG8_SA(1, 0), a3, voffA);
            PG8_BAR; PG8_WAIT_L(0); PG8_MMA(1, 0, At, B0); PG8_BAR; PG8_SCHED;
            PG8_STAGE(PG8_SB(1, 1), b3 + hstep, voffB);
            PG8_WAIT_V(6); PG8_BAR; PG8_MMA(1, 1, At, B1); PG8_BAR;
            }
        }
        if constexpr (ALIGN_EPI) { if (wr == 0) PG8_BAR; }
        if constexpr (!Epi::AFTER_DRAIN) { E(acc, cur, wr, wc, fr, fq); S.done(cur); }
        if (!has_next) break;
#pragma unroll
        for (int a = 0; a < 2; ++a)
#pragma unroll
            for (int b = 0; b < 2; ++b)
#pragma unroll
                for (int m = 0; m < 4; ++m)
#pragma unroll
                    for (int n = 0; n < 2; ++n) acc[a][b][m][n] = (f32x4){0.f, 0.f, 0.f, 0.f};
        cur = nxt; cA = nA; cB = nB; ++ui;
        if constexpr (ALIGN_EPI) { if (wr == 1) PG8_BAR; }
    }
    PG8_WAIT_V(0);
    if constexpr (!ALIGN_EPI) { if (wr == 0) PG8_BAR; }
    PG8_BAR;
    if constexpr (Epi::AFTER_DRAIN) { E.fused(acc, cur, wr, wc, fr, fq, lds, wid, lane); S.done(cur); }
#undef PG8_SA
#undef PG8_SB
#undef PG8_STAGE
#undef PG8_LDA
#undef PG8_LDB
#undef PG8_MMA
#undef PG8_WAIT_V
#undef PG8_WAIT_L
#undef PG8_BAR
#undef PG8_SCHED
}
}
#ifndef REP_RG
#define REP_RG 1
#endif
#ifndef REP_AGG
#define REP_AGG 1
#endif
#ifndef REP_HY
#define REP_HY 1
#endif
#ifndef REP_GIN
#define REP_GIN 1
#endif
#ifndef REP_GUP
#define REP_GUP 1
#endif
#ifndef REP_NORM
#define REP_NORM 1
#endif
#ifndef REP_P0
#define REP_P0 1
#endif
#ifndef REP_P1
#define REP_P1 1
#endif
constexpr int NWAVES = 8;
constexpr int D = 1024, M = 16384, MCTX = 8192, DFF = 2816, NIN = 3840, DIN = 3600;
constexpr float EPS = 1e-6f;
constexpr size_t MiB = 1u << 20;
constexpr size_t WS_CTL = 0, CTL_ZERO_BYTES = MiB;
constexpr size_t WS_MOD = 512 * 1024;
constexpr size_t WS_SMALL = 1 * MiB;
constexpr size_t WS_PE = WS_SMALL + 147456;
constexpr size_t WS_RGW = WS_PE + 131072;
constexpr size_t WS_RGAGG = WS_RGW + 262144;
constexpr size_t WS_GD = WS_RGAGG + 131072;
static_assert(WS_GD + 131072 <= 2 * MiB, "small region");
constexpr size_t WS_H2 = 2 * MiB;
constexpr size_t WS_HT = 5 * MiB;
constexpr size_t WS_HTC = 21 * MiB;
constexpr size_t WS_WIN = 22 * MiB, WS_WOUT = WS_WIN + (size_t)NIN * D * 2, WS_W13 = WS_WOUT + (size_t)D * D * 2, WS_W2 = WS_W13 + (size_t)2 * DFF * D * 2;
static_assert(WS_W2 + (size_t)D * DFF * 2 == 48 * MiB, "weights fill [22,48) MiB");
constexpr size_t WS_XN = 48 * MiB;
constexpr size_t WS_PROJ = 80 * MiB;
constexpr size_t WS_CT = 169 * MiB, WS_CT2 = 185 * MiB;
constexpr size_t WS_OSUM = 193 * MiB;
constexpr size_t WS_RGH = 225 * MiB, WS_RGP = 233 * MiB;
constexpr size_t WS_GS = 241 * MiB, WS_END = 249 * MiB;
constexpr size_t OUT_YS = 8388608, OUT_SGLA = 16777216, OUT_SRG = 18874368, OUT_SHG = 18907136, OUT_END = 21004288;
constexpr int CW_BAR = 4096;
constexpr int RING_BYTES = 131072, LDS_BYTES = 147456, LDSCTL_OFF = LDS_BYTES - 512, MISC_OFF = LDSCTL_OFF + 320;

#define GAS __attribute__((address_space(1)))
#define LAS __attribute__((address_space(3)))
typedef unsigned short bf16;
typedef unsigned v4u __attribute__((ext_vector_type(4)));
typedef unsigned v2u __attribute__((ext_vector_type(2)));
typedef float f32x4 __attribute__((ext_vector_type(4)));
typedef float f32x2 __attribute__((ext_vector_type(2)));
typedef short bf16x8 __attribute__((ext_vector_type(8)));
typedef short bf16x4 __attribute__((ext_vector_type(4)));
typedef GAS unsigned gu32;
#define RLX_AGENT __ATOMIC_RELAXED, __HIP_MEMORY_SCOPE_AGENT
#define LDS_WAIT() asm volatile("s_waitcnt lgkmcnt(0)" ::: "memory")
#define VM_WAIT() asm volatile("s_waitcnt vmcnt(0)" ::: "memory")
__device__ __forceinline__ unsigned pk2(float lo, float hi) { return __builtin_amdgcn_perm(__builtin_bit_cast(unsigned, hi) + 0x8000u, __builtin_bit_cast(unsigned, lo) + 0x8000u, 0x07060302u); }
__device__ __forceinline__ v2u pk4(float a, float b, float c, float d) { v2u r; r.x = pk2(a, b); r.y = pk2(c, d); return r; }
__device__ __forceinline__ v4u pk8(float a0, float a1, float a2, float a3, float a4, float a5, float a6, float a7) { v4u r; r.x = pk2(a0, a1); r.y = pk2(a2, a3); r.z = pk2(a4, a5); r.w = pk2(a6, a7); return r; }
__device__ __forceinline__ unsigned f2bf(float f) { return (__builtin_bit_cast(unsigned, f) + 0x8000u) >> 16; }
__device__ __forceinline__ float bf2f(unsigned h) { return __builtin_bit_cast(float, h << 16); }
__device__ __forceinline__ float bflo(unsigned w) { return __builtin_bit_cast(float, w << 16); }
__device__ __forceinline__ float bfhi(unsigned w) { return __builtin_bit_cast(float, w & 0xffff0000u); }
__device__ __forceinline__ float wave_sum(float v) {
#pragma unroll
    for (int o = 1; o < 64; o <<= 1) v += __shfl_xor(v, o);
    return v;
}
__device__ __forceinline__ float sigmoidf_(float x) { return 1.f / (1.f + __expf(-x)); }
#define XB_TMO      128
#define XB_XCNT(j)  (256  + 64 * (j))
#define XB_XSUB(j)  (1280 + 64 * (j))
#define XB_XGEN(j)  (2304 + 64 * (j))
#define XB_TOP      3328
#define XB_TOPGEN   3392
#define XCD_BAR_WORDS 3456
#define XB_SPIN_CAP (1u << 18)

__device__ __forceinline__ unsigned xb_ld(unsigned* p)              { return __hip_atomic_load(p, __ATOMIC_RELAXED, __HIP_MEMORY_SCOPE_AGENT); }
__device__ __forceinline__ unsigned xb_add(unsigned* p, unsigned v) { return __hip_atomic_fetch_add(p, v, __ATOMIC_RELAXED, __HIP_MEMORY_SCOPE_AGENT); }
__device__ __forceinline__ unsigned xb_xcc_id() { return (unsigned)__builtin_amdgcn_s_getreg((3 << 11) | 20) & 0xFu; }
#define XB_SPIN(cond, bar) do { unsigned _sp = 0; while (cond) { __builtin_amdgcn_s_sleep(1); \
    if ((++_sp & 255u) == 0u) { if (xb_ld(&(bar)[XB_TMO])) break; if (_sp > XB_SPIN_CAP) { atomicAdd(&(bar)[XB_TMO], 1u); break; } } } } while (0)

struct XcdBarrier {
    unsigned* bar; unsigned x;
    volatile LAS unsigned* st;
};

__device__ __forceinline__ XcdBarrier xcd_barrier_post(unsigned* bar, volatile LAS unsigned* st) {
    XcdBarrier b; b.bar = bar; b.x = xb_xcc_id(); b.st = st;
    if (threadIdx.x == 0) (void)xb_add(&bar[XB_XCNT(b.x)], 1u);
    return b;
}
__device__ __forceinline__ void xcd_barrier_complete(unsigned* bar, unsigned x, unsigned& nloc, unsigned& nx) {
    const unsigned G = gridDim.x * gridDim.y * gridDim.z;
    unsigned sum, cnt, mine, sp = 0u;
    for (;;) {
        sum = 0u; cnt = 0u; mine = 0u;
#pragma unroll
        for (unsigned j = 0; j < 16; ++j) { const unsigned c = xb_ld(&bar[XB_XCNT(j)]); sum += c; cnt += (c > 0u) ? 1u : 0u; mine = (j == x) ? c : mine; }
        if (sum == G) break;
        __builtin_amdgcn_s_sleep(1);
        if ((++sp & 255u) == 0u) { if (xb_ld(&bar[XB_TMO])) break; if (sp > XB_SPIN_CAP) { atomicAdd(&bar[XB_TMO], 1u); break; } }
    }
    nloc = mine > 0u ? mine : 1u; nx = cnt > 0u ? cnt : 1u;
}

__device__ __forceinline__ void xcd_barrier(const XcdBarrier& b) {
    asm volatile("s_waitcnt vmcnt(0)" ::: "memory");
    __syncthreads();
    if (threadIdx.x == 0) {
        unsigned* bar = b.bar;
        __builtin_amdgcn_s_waitcnt(0);
        unsigned nloc = b.st[0], nx = b.st[1];
        if (nloc == 0u) { xcd_barrier_complete(bar, b.x, nloc, nx); b.st[0] = nloc; b.st[1] = nx; }
        const unsigned old = xb_add(&bar[XB_XSUB(b.x)], 1u);
        const unsigned gen = old / nloc;
        if (old + 1u == (gen + 1u) * nloc) {
            __builtin_amdgcn_fence(__ATOMIC_RELEASE, "agent");
            asm volatile("s_waitcnt vmcnt(0)" ::: "memory");
            const unsigned og = xb_add(&bar[XB_TOP], 1u);
            const unsigned tg = og / nx;
            if (og + 1u == (tg + 1u) * nx) xb_add(&bar[XB_TOPGEN], 1u);
            else XB_SPIN(xb_ld(&bar[XB_TOPGEN]) == tg, bar);
            __builtin_amdgcn_fence(__ATOMIC_ACQUIRE, "agent");
            xb_add(&bar[XB_XGEN(b.x)], 1u);
            asm volatile("s_waitcnt vmcnt(0)" ::: "memory");
        } else {
            XB_SPIN(xb_ld(&bar[XB_XGEN(b.x)]) == gen, bar);
            __builtin_amdgcn_fence(__ATOMIC_ACQUIRE, "agent");
            asm volatile("s_waitcnt vmcnt(0)" ::: "memory");
        }
    }
    __syncthreads();
}
struct Ctx { LAS unsigned char* lds; int tid, lane, wave, vcu, G; };
__device__ __forceinline__ Ctx make_ctx(LAS unsigned char* lds) {
    Ctx C; C.lds = lds; int t = threadIdx.x; asm volatile("" : "+v"(t)); C.tid = t; C.lane = t & 63; C.wave = __builtin_amdgcn_readfirstlane(t >> 6);
    C.G = gridDim.x; { const int bx = blockIdx.x; C.vcu = (C.G % 8 == 0) ? (bx % 8) * (C.G / 8) + bx / 8 : bx; }
    return C;
}
typedef const float* fptr_t;
#define KARG ((const __attribute__((address_space(4))) fptr_t*)__builtin_amdgcn_kernarg_segment_ptr())
#define INP(i) (KARG[(i)])
#define OUTP ((float*)KARG[N_IN])
#define WSP ((unsigned char*)KARG[N_IN + 1])
enum { I_XP = 0, I_XS, I_SGLA, I_SRG, I_SHG, I_C, I_CCTX, I_N1G, I_N2G, I_FNG, I_WMOD, I_BMOD, I_WIN, I_WOUT, I_GLAWG, I_GLABG, I_GLANG,
       I_RGCW, I_RGCB, I_RGWA, I_RGBA, I_RGWX, I_RGBX, I_RGLAM, I_HYCW, I_HYCB, I_HYW1, I_HYB1, I_HYW2, I_HYB2, I_HYW3, I_HYDEC, I_HYSKIP,
       I_HGLOW, I_HGNG, I_FW1, I_FW3, I_FW2, N_IN };

__device__ __forceinline__ void transpose_tile(const float* W, int ldw, int k0, int c0, int nvalid, bf16* WT, int ldt, int r0, LAS float* scr, int lane) {
    const int n_ = lane & 31;
    float tv[32];
    const float* Wp = W + (size_t)(k0 + (lane >> 5)) * ldw + c0 + n_;
#pragma unroll
    for (int i = 0; i < 32; ++i) tv[i] = (n_ < nvalid) ? Wp[(size_t)(2 * i) * ldw] : 0.f;
#pragma unroll
    for (int i = 0; i < 32; ++i) scr[(2 * i + (lane >> 5)) * 33 + n_] = tv[i];
    LDS_WAIT(); asm volatile("" ::: "memory");
    const int c = lane & 7;
#pragma unroll
    for (int j = 0; j < 4; ++j) { const int n = (lane >> 3) + 8 * j; const LAS float* s = scr + (8 * c) * 33 + n;
        const v4u o = pk8(s[0 * 33], s[1 * 33], s[2 * 33], s[3 * 33], s[4 * 33], s[5 * 33], s[6 * 33], s[7 * 33]);
        *(GAS v4u*)(WT + (size_t)(r0 + n) * ldt + k0 + 8 * c) = o; }
    LDS_WAIT(); asm volatile("" ::: "memory");
}
__device__ __forceinline__ void convert_weights(const Ctx& C, int l) {
    LAS float* scr = (LAS float*)(C.lds + C.wave * 16384);
    const int gw = C.vcu * NWAVES + C.wave, NGW = C.G * NWAVES;
    constexpr int I_IN = 16 * 120, I_OUT = 16 * 32, I_13 = 16 * 176, I_2 = 44 * 32, NITEMS = I_IN + I_OUT + I_13 + I_2;
    const float* win = INP(I_WIN) + (size_t)l * D * DIN; const float* wout = INP(I_WOUT) + (size_t)l * D * D;
    const float* w1 = INP(I_FW1) + (size_t)l * D * DFF; const float* w3 = INP(I_FW3) + (size_t)l * D * DFF; const float* w2 = INP(I_FW2) + (size_t)l * DFF * D;
    bf16* WinT = (bf16*)(WSP + WS_WIN); bf16* WoutT = (bf16*)(WSP + WS_WOUT); bf16* W13T = (bf16*)(WSP + WS_W13); bf16* W2T = (bf16*)(WSP + WS_W2);
    for (int it = gw; it < NITEMS; it += NGW) {
        int r = it;
        if (r < I_IN) { const int kb = r / 120, nb = r % 120, n0 = 32 * nb; int src, nv = 32;
            if (n0 < 768) src = 1552 + n0; else if (n0 < 1792) src = n0 - 768; else if (n0 < 2304) src = 1040 + (n0 - 1792); else if (n0 < 3584) src = 2320 + (n0 - 2304);
            else if (n0 == 3584) { src = 1024; nv = 16; } else { src = 0; nv = 0; }
            transpose_tile(win, DIN, 64 * kb, src, nv, WinT, D, n0, scr, C.lane); continue; } r -= I_IN;
        if (r < I_OUT) { const int kb = r / 32, nb = r % 32; transpose_tile(wout, D, 64 * kb, 32 * nb, 32, WoutT, D, 32 * nb, scr, C.lane); continue; } r -= I_OUT;
        if (r < I_13) { const int kb = r / 176, nb = r % 176, n0 = 32 * nb, tile = n0 >> 8, j = n0 & 255;
            transpose_tile(j < 128 ? w1 : w3, DFF, 64 * kb, 128 * tile + (j & 127), 32, W13T, D, n0, scr, C.lane); continue; } r -= I_13;
        { const int kb = r / 32, nb = r % 32; transpose_tile(w2, D, 64 * kb, 32 * nb, 32, W2T, DFF, 32 * nb, scr, C.lane); }
    }
}
__device__ __forceinline__ void mod_gemv(const Ctx& C) {
    LAS float* sc = (LAS float*)C.lds;
    for (int i = C.tid; i < 3072; i += NWAVES * 64) { const int r = i >> 10, k = i & 1023; const float v = (r == 0) ? INP(I_CCTX)[k] : INP(I_C)[(r - 1) * 1024 + k]; sc[i] = v * sigmoidf_(v); }
    __syncthreads();
    float* mod = (float*)(WSP + WS_MOD);
    const int gw = C.vcu * NWAVES + C.wave, NGW = C.G * NWAVES;
    for (int item = gw; item < 2 * 24 * 32; item += NGW) {
        const int kc = item & 31, cc = (item >> 5) % 24, l = item / (24 * 32), col = cc * 256 + 4 * C.lane;
        const float* w = INP(I_WMOD) + ((size_t)l * 1024 + kc * 32) * 6144 + col;
        f32x4 wv[32];
#pragma unroll
        for (int k = 0; k < 32; ++k) wv[k] = *(const f32x4*)(w + (size_t)k * 6144);
        f32x4 a0 = (f32x4){0.f, 0.f, 0.f, 0.f}, a1 = a0, a2 = a0;
#pragma unroll
        for (int k = 0; k < 32; ++k) { a0 += wv[k] * sc[kc * 32 + k]; a1 += wv[k] * sc[1024 + kc * 32 + k]; a2 += wv[k] * sc[2048 + kc * 32 + k]; }
        if (kc == 0) { const f32x4 b = *(const f32x4*)(INP(I_BMOD) + l * 6144 + col); a0 += b; a1 += b; a2 += b; }
        float* m0 = mod + ((size_t)l * 3) * 6144 + col;
#pragma unroll
        for (int e = 0; e < 4; ++e) { atomicAdd(m0 + e, a0[e]); atomicAdd(m0 + 6144 + e, a1[e]); atomicAdd(m0 + 2 * 6144 + e, a2[e]); }
    }
}
__device__ __forceinline__ void h2_rows(const Ctx& C) {
    const int gw = C.vcu * NWAVES + C.wave, NGW = C.G * NWAVES;
    float* H2 = (float*)(WSP + WS_H2);
    for (int rw = gw; rw < 2 * 4352; rw += NGW) {
        const int l = rw / 4352, rr = rw % 4352; const int L = rr < 4096 ? 4096 : 256, pos = rr < 4096 ? rr : rr - 4096;
        float pe = 0.f;
        if (C.lane == 0) pe = (float)pos / (float)(L - 1);
        else if (C.lane < 33) { const int b = (C.lane - 1) & 15; const double band = 1e-4 + (double)b * ((15.0 - 1e-4) / 15.0);
            double x = (double)pos * band / (double)L; x -= floor(x); float s, c; sincospif((float)(2.0 * x), &s, &c); pe = (C.lane < 17) ? c : -s; }
        const float* w1 = INP(I_HYW1) + l * 33 * 64; const float* w2 = INP(I_HYW2) + l * 64 * 64;
        float a = INP(I_HYB1)[l * 64 + C.lane];
#pragma unroll
        for (int i = 0; i < 33; ++i) a += __shfl(pe, i) * w1[i * 64 + C.lane];
        const float h1 = sinf(a);
        float b = INP(I_HYB2)[l * 64 + C.lane];
#pragma unroll 16
        for (int i = 0; i < 64; ++i) b += __shfl(h1, i) * w2[i * 64 + C.lane];
        H2[(size_t)l * 278528 + (rr < 4096 ? (size_t)C.lane * 4096 + pos : (size_t)262144 + C.lane * 256 + pos)] = sinf(b);
    }
}
__device__ __forceinline__ void p0_prologue(const Ctx& C) {
    mod_gemv(C);
    __syncthreads();
    convert_weights(C, 0);
    h2_rows(C);
    const int gt = C.vcu * NWAVES * 64 + C.tid, NGT = C.G * NWAVES * 64;
    float* PE = (float*)(WSP + WS_PE);
    for (int i = gt; i < 64 * 512; i += NGT) { const int p = i >> 9, j = i & 511, jj = j & 255; const float om = expf(-(float)jj * (9.210340371976184f / 256.f)); const float ang = (float)p * om; PE[i] = (j < 256) ? sinf(ang) : cosf(ang); }
    bf16* RGW = (bf16*)(WSP + WS_RGW);
    for (int i = gt; i < 2 * 2 * 2 * 4 * 4096; i += NGT) {
        const int i_ = i & 63, j = (i >> 6) & 63, hb = (i >> 12) & 3, gate = (i >> 14) & 1, d = (i >> 15) & 1, l = i >> 16;
        const float* src = INP(gate ? I_RGWX : I_RGWA) + ((((size_t)l * 2 + d) * 4 + hb) * 64 + i_) * 64 + j;
        RGW[i] = (bf16)f2bf(*src); }
}
__device__ __forceinline__ int cond_row(int m) { return m < MCTX ? 0 : 1 + ((m - MCTX) >> 12); }
template <bool INIT>
__device__ __forceinline__ void norm_rows(const Ctx& C, const float* gamma, const float* modl, int off_sh, int off_sc) {
    const int gw = C.vcu * NWAVES + C.wave, NGW = C.G * NWAVES;
    float* X = OUTP; bf16* XN = (bf16*)(WSP + WS_XN); const float* PE = (const float*)(WSP + WS_PE);
    for (int m = gw; m < M; m += NGW) {
        const int r = cond_row(m); const float* md = modl + r * 6144;
        f32x4 v[4]; float ss = 0.f;
#pragma unroll
        for (int j = 0; j < 4; ++j) { const int col = 256 * j + 4 * C.lane;
            if (INIT) { if (m < MCTX) v[j] = *(const f32x4*)(INP(I_XP) + (size_t)m * D + col);
                else { const int t = (m - MCTX) & 4095; const int p = (j < 2) ? (t >> 6) : (t & 63);
                    v[j] = *(const f32x4*)(INP(I_XS) + (size_t)(m - MCTX) * D + col) + *(const f32x4*)(PE + p * 512 + (col & 511)); }
                *(f32x4*)(X + (size_t)m * D + col) = v[j]; }
            else v[j] = *(const f32x4*)(X + (size_t)m * D + col);
            ss += (v[j].x * v[j].x + v[j].y * v[j].y) + (v[j].z * v[j].z + v[j].w * v[j].w); }
        const float rstd = 1.f / sqrtf(wave_sum(ss) * (1.f / D) + EPS);
#pragma unroll
        for (int j = 0; j < 4; ++j) { const int col = 256 * j + 4 * C.lane;
            const f32x4 g = *(const f32x4*)(gamma + col), sc = *(const f32x4*)(md + off_sc + col), sh = *(const f32x4*)(md + off_sh + col);
            const f32x4 u = (v[j] * rstd) * g * (sc + 1.f) + sh;
            const v2u o = pk4(u.x, u.y, u.z, u.w);
            *(GAS v2u*)(XN + (size_t)m * D + col) = o; }
    }
}
__device__ __forceinline__ void final_norm(const Ctx& C) {
    const int gw = C.vcu * NWAVES + C.wave, NGW = C.G * NWAVES; float* X = OUTP; const float* gamma = INP(I_FNG);
    for (int m = gw; m < M; m += NGW) {
        f32x4 v[4]; float ss = 0.f;
#pragma unroll
        for (int j = 0; j < 4; ++j) { v[j] = *(const f32x4*)(X + (size_t)m * D + 256 * j + 4 * C.lane); ss += (v[j].x * v[j].x + v[j].y * v[j].y) + (v[j].z * v[j].z + v[j].w * v[j].w); }
        const float rstd = 1.f / sqrtf(wave_sum(ss) * (1.f / D) + EPS);
#pragma unroll
        for (int j = 0; j < 4; ++j) { const int col = 256 * j + 4 * C.lane; *(f32x4*)(X + (size_t)m * D + col) = (v[j] * rstd) * *(const f32x4*)(gamma + col); }
    }
}
__device__ __forceinline__ void hyena_filters(const Ctx& C) {
    LAS float* w3s = (LAS float*)C.lds;
    LAS float* red = w3s + 2048;
    const float* H2 = (const float*)(WSP + WS_H2);
    for (int u = C.vcu; u < 256 + 32; u += C.G) {
        __syncthreads();
        if (u < 256) {
            const int l = u >> 7, f0 = (u & 127) * 4;
            if (C.tid < 256) { const int j = C.tid >> 2, e = C.tid & 3; w3s[j * 4 + e] = INP(I_HYW3)[((size_t)l * 64 + j) * 512 + f0 + e]; }
            __syncthreads();
            float hv[8][4];
#pragma unroll
            for (int i = 0; i < 8; ++i)
#pragma unroll
                for (int e = 0; e < 4; ++e) hv[i][e] = 0.f;
            const float* hb = H2 + (size_t)l * 278528 + C.tid;
#pragma unroll 4
            for (int j = 0; j < 64; ++j) { const f32x4 wv = *(const LAS f32x4*)(w3s + j * 4);
#pragma unroll
                for (int i = 0; i < 8; ++i) { const float h = hb[(size_t)j * 4096 + 512 * i]; hv[i][0] += h * wv.x; hv[i][1] += h * wv.y; hv[i][2] += h * wv.z; hv[i][3] += h * wv.w; } }
            float sm[4];
#pragma unroll
            for (int e = 0; e < 4; ++e) { const float dec = INP(I_HYDEC)[l * 512 + f0 + e]; float s = 0.f;
#pragma unroll
                for (int i = 0; i < 8; ++i) { const int t = C.tid + 512 * i; const float dist = fabsf((float)(t - 2048)) * (1.f / 2048.f); hv[i][e] *= expf(-dist * dec); s += fabsf(hv[i][e]); }
                sm[e] = wave_sum(s); }
            if (C.lane == 0) {
#pragma unroll
                for (int e = 0; e < 4; ++e) red[C.wave * 16 + e] = sm[e]; }
            __syncthreads();
#pragma unroll
            for (int e = 0; e < 4; ++e) { float tot = 0.f;
#pragma unroll
                for (int w8 = 0; w8 < 8; ++w8) tot += red[w8 * 16 + e];
                const float inv = 1.f / tot; float* dst = (float*)(WSP + WS_HT) + ((size_t)l * 512 + f0 + e) * 4096 + C.tid;
#pragma unroll
                for (int i = 0; i < 8; ++i) dst[512 * i] = hv[i][e] * inv; }
        } else {
            const int uu = u - 256, l = uu >> 4, f0 = (uu & 15) * 32, t = C.tid & 255, fh = C.tid >> 8;
            for (int i = C.tid; i < 2048; i += 512) { const int j = i >> 5, e = i & 31; w3s[i] = INP(I_HYW3)[((size_t)l * 64 + j) * 512 + f0 + e]; }
            __syncthreads();
            float hv[16];
#pragma unroll
            for (int e = 0; e < 16; ++e) hv[e] = 0.f;
            const float* hb = H2 + (size_t)l * 278528 + 262144 + t;
#pragma unroll 4
            for (int j = 0; j < 64; ++j) { const float h = hb[j * 256];
#pragma unroll
                for (int q = 0; q < 4; ++q) { const f32x4 wv = *(const LAS f32x4*)(w3s + j * 32 + 16 * fh + 4 * q); hv[4 * q] += h * wv.x; hv[4 * q + 1] += h * wv.y; hv[4 * q + 2] += h * wv.z; hv[4 * q + 3] += h * wv.w; } }
            const float dist = fabsf((float)(t - 128)) * (1.f / 128.f);
#pragma unroll
            for (int e = 0; e < 16; ++e) { hv[e] *= expf(-dist * INP(I_HYDEC)[l * 512 + f0 + 16 * fh + e]); const float s = wave_sum(fabsf(hv[e])); if (C.lane == 0) red[C.wave * 16 + e] = s; }
            __syncthreads();
#pragma unroll
            for (int e = 0; e < 16; ++e) { const float tot = red[(4 * fh + 0) * 16 + e] + red[(4 * fh + 1) * 16 + e] + red[(4 * fh + 2) * 16 + e] + red[(4 * fh + 3) * 16 + e];
                ((float*)(WSP + WS_HTC))[((size_t)l * 512 + f0 + 16 * fh + e) * 256 + t] = hv[e] / tot; }
        }
    }
}
__device__ __forceinline__ float gelu_tanh(float x) { const float u = 0.7978845608028654f * (x + 0.044715f * x * x * x); const float t = 1.f - 2.f / (1.f + __expf(2.f * u)); return 0.5f * x * (1.f + t); }
__device__ __forceinline__ float softplusf_(float z) { return fmaxf(z, 0.f) + log1pf(__expf(-fabsf(z))); }
__device__ __forceinline__ bf16x8 pack_bf16x8(f32x4 a, f32x4 b) {
    return __builtin_bit_cast(bf16x8, pk8(a.x, a.y, a.z, a.w, b.x, b.y, b.z, b.w));
}
__device__ __forceinline__ void rg_main(const Ctx& C, int l, int u) {
    const int seg = u >> 2, hb = u & 3; const bool lat = seg >= 32; const int m0 = seg * 256;
    const int sbeg = lat ? MCTX + ((seg - 32) >> 4) * 4096 : m0, send = lat ? sbeg + 4096 : m0 + 256;
    LAS float* xc = (LAS float*)C.lds; LAS float* hs = xc + 256 * 68;
    const bf16* PROJ = (const bf16*)(WSP + WS_PROJ);
    {
        const int t = C.tid >> 1, c0 = 32 * (C.tid & 1), chg = 64 * hb + c0;
        float acc[32];
        const float* cb = INP(I_RGCB) + l * 256 + chg;
#pragma unroll
        for (int e = 0; e < 32; e += 4) { const f32x4 b = *(const f32x4*)(cb + e); acc[e] = b.x; acc[e + 1] = b.y; acc[e + 2] = b.z; acc[e + 3] = b.w; }
#pragma unroll
        for (int j = 0; j < 4; ++j) { const int mr = m0 + t - 2 + j;
            if (mr >= sbeg && mr < send) { const v4u* xp = (const v4u*)(PROJ + (size_t)mr * pg8::PROJ_LD + 1024 + chg); const float* wp = INP(I_RGCW) + (l * 4 + j) * 256 + chg;
#pragma unroll
                for (int q = 0; q < 4; ++q) { const v4u xv = xp[q]; const f32x4 w0 = *(const f32x4*)(wp + 8 * q), w1 = *(const f32x4*)(wp + 8 * q + 4);
                    acc[8 * q + 0] += w0.x * bflo(xv.x); acc[8 * q + 1] += w0.y * bfhi(xv.x); acc[8 * q + 2] += w0.z * bflo(xv.y); acc[8 * q + 3] += w0.w * bfhi(xv.y);
                    acc[8 * q + 4] += w1.x * bflo(xv.z); acc[8 * q + 5] += w1.y * bfhi(xv.z); acc[8 * q + 6] += w1.z * bflo(xv.w); acc[8 * q + 7] += w1.w * bfhi(xv.w); } } }
#pragma unroll
        for (int e = 0; e < 32; e += 4) { *(LAS f32x4*)(xc + t * 68 + c0 + e) = (f32x4){acc[e], acc[e + 1], acc[e + 2], acc[e + 3]}; *(LAS f32x4*)(hs + t * 68 + c0 + e) = (f32x4){0.f, 0.f, 0.f, 0.f}; }
    }
    __syncthreads();
    {
        const int dir = C.wave >> 2, nt = C.wave & 3, cl = C.lane & 15, g = C.lane >> 4, ch = 16 * nt + cl, chg = 64 * hb + ch;
        const bf16* wb = (const bf16*)(WSP + WS_RGW) + ((size_t)(((l * 2 + dir) * 2 + 0) * 4 + hb) * 64 + ch) * 64 + 8 * g;
        const bf16x8 Ba0 = *(const bf16x8*)(wb), Ba1 = *(const bf16x8*)(wb + 32), Bx0 = *(const bf16x8*)(wb + 16384), Bx1 = *(const bf16x8*)(wb + 16384 + 32);
        const float ba = INP(I_RGBA)[(l * 2 + dir) * 256 + chg], bx = INP(I_RGBX)[(l * 2 + dir) * 256 + chg];
        const float c1 = -8.f * softplusf_(-INP(I_RGLAM)[(l * 2 + dir) * 256 + chg]);
        bf16* RGP = (bf16*)(WSP + WS_RGP) + (size_t)dir * 8192 * 256;
        float carry = 0.f, pc = 1.f;
#pragma unroll 1
        for (int it = 0; it < 16; ++it) {
            const int t0 = 16 * (dir ? 15 - it : it);
            const LAS float* xr = xc + (t0 + cl) * 68 + 8 * g;
            const bf16x8 A0 = pack_bf16x8(*(const LAS f32x4*)(xr), *(const LAS f32x4*)(xr + 4)), A1 = pack_bf16x8(*(const LAS f32x4*)(xr + 32), *(const LAS f32x4*)(xr + 36));
            f32x4 ar = (f32x4){0.f, 0.f, 0.f, 0.f}, ax = ar;
            ar = __builtin_amdgcn_mfma_f32_16x16x32_bf16(A0, Ba0, ar, 0, 0, 0); ar = __builtin_amdgcn_mfma_f32_16x16x32_bf16(A1, Ba1, ar, 0, 0, 0);
            ax = __builtin_amdgcn_mfma_f32_16x16x32_bf16(A0, Bx0, ax, 0, 0, 0); ax = __builtin_amdgcn_mfma_f32_16x16x32_bf16(A1, Bx1, ax, 0, 0, 0);
            float a[4], uu[4];
#pragma unroll
            for (int r = 0; r < 4; ++r) { const float xv = xc[(t0 + 4 * g + r) * 68 + ch]; const float rr = sigmoidf_(ar[r] + ba), ii = sigmoidf_(ax[r] + bx);
                const float la = c1 * rr; a[r] = __expf(la); uu[r] = sqrtf(-expm1f(2.f * la)) * ii * xv; }
            const float Aloc = (a[0] * a[1]) * (a[2] * a[3]);
            const float Uloc = dir ? ((uu[3] * a[2] + uu[2]) * a[1] + uu[1]) * a[0] + uu[0] : ((uu[0] * a[1] + uu[1]) * a[2] + uu[2]) * a[3] + uu[3];
            float hin = carry, pin = pc;
            if (!dir) {
#pragma unroll
                for (int gp = 0; gp < 3; ++gp) { const float Ag = __shfl(Aloc, cl + 16 * gp), Ug = __shfl(Uloc, cl + 16 * gp); if (gp < g) { hin = Ag * hin + Ug; pin *= Ag; } }
            } else {
#pragma unroll
                for (int gp = 3; gp > 0; --gp) { const float Ag = __shfl(Aloc, cl + 16 * gp), Ug = __shfl(Uloc, cl + 16 * gp); if (gp > g) { hin = Ag * hin + Ug; pin *= Ag; } }
            }
            float h[4], p[4];
            if (!dir) { h[0] = a[0] * hin + uu[0]; h[1] = a[1] * h[0] + uu[1]; h[2] = a[2] * h[1] + uu[2]; h[3] = a[3] * h[2] + uu[3];
                        p[0] = pin * a[0]; p[1] = p[0] * a[1]; p[2] = p[1] * a[2]; p[3] = p[2] * a[3];
                        carry = __shfl(h[3], 48 + cl); pc = __shfl(p[3], 48 + cl); }
            else      { h[3] = a[3] * hin + uu[3]; h[2] = a[2] * h[3] + uu[2]; h[1] = a[1] * h[2] + uu[1]; h[0] = a[0] * h[1] + uu[0];
                        p[3] = pin * a[3]; p[2] = p[3] * a[2]; p[1] = p[2] * a[1]; p[0] = p[1] * a[0];
                        carry = __shfl(h[0], cl); pc = __shfl(p[0], cl); }
#pragma unroll
            for (int r = 0; r < 4; ++r) { const int t = t0 + 4 * g + r;
                (void)__hip_atomic_fetch_add(hs + t * 68 + ch, h[r], __ATOMIC_RELAXED, __HIP_MEMORY_SCOPE_WORKGROUP);
                if (lat) RGP[(size_t)(m0 - MCTX + t) * 256 + chg] = (bf16)f2bf(p[r]); }
        }
        if (g == 0) {
            if (lat) { float* ag = (float*)(WSP + WS_RGAGG) + ((size_t)((seg - 32) * 2 + dir) * 256 + chg) * 2; ag[0] = pc; ag[1] = carry; }
            else OUTP[OUT_SRG + ((size_t)(seg * 2 + l) * 2 + dir) * 256 + chg] = carry;
        }
    }
    __syncthreads();
    {
        const int t = C.tid >> 1, c0 = 32 * (C.tid & 1), chg = 64 * hb + c0, m = m0 + t;
        if (!lat) {
            const v4u* gp = (const v4u*)(PROJ + (size_t)m * pg8::PROJ_LD + 1280 + chg); bf16* yp = (bf16*)(WSP + WS_XN) + (size_t)m * 1024 + 256 + chg;
#pragma unroll
            for (int q = 0; q < 4; ++q) { const v4u gv = gp[q]; const f32x4 h0 = *(const LAS f32x4*)(hs + t * 68 + c0 + 8 * q), h1 = *(const LAS f32x4*)(hs + t * 68 + c0 + 8 * q + 4);
                v4u o; o.x = pk2(h0.x * gelu_tanh(bflo(gv.x)), h0.y * gelu_tanh(bfhi(gv.x))); o.y = pk2(h0.z * gelu_tanh(bflo(gv.y)), h0.w * gelu_tanh(bfhi(gv.y)));
                o.z = pk2(h1.x * gelu_tanh(bflo(gv.z)), h1.y * gelu_tanh(bfhi(gv.z))); o.w = pk2(h1.z * gelu_tanh(bflo(gv.w)), h1.w * gelu_tanh(bfhi(gv.w)));
                *(GAS v4u*)(yp + 8 * q) = o; }
        } else {
            float* hp = (float*)(WSP + WS_RGH) + (size_t)(m - MCTX) * 256 + chg;
#pragma unroll
            for (int q = 0; q < 8; ++q) *(f32x4*)(hp + 4 * q) = *(const LAS f32x4*)(hs + t * 68 + c0 + 4 * q);
        }
    }
    __syncthreads();
}
__device__ __forceinline__ void rg_corr(const Ctx& C, int l, int u) {
    const int segl = u >> 2, cg = u & 3, b = segl >> 4, j = segl & 15;
    LAS float* hin = (LAS float*)C.lds;
    __syncthreads();
    if (C.tid < 128) { const int dir = C.tid >> 6, c = C.tid & 63, chg = 64 * cg + c;
        float h = INP(I_SRG)[((size_t)(b * 2 + l) * 2 + dir) * 256 + chg];
        const float* ag = (const float*)(WSP + WS_RGAGG);
        if (dir == 0) { for (int i = 0; i < j; ++i) { const float* a2 = ag + ((size_t)((b * 16 + i) * 2 + 0) * 256 + chg) * 2; h = a2[0] * h + a2[1]; } }
        else { for (int i = 15; i > j; --i) { const float* a2 = ag + ((size_t)((b * 16 + i) * 2 + 1) * 256 + chg) * 2; h = a2[0] * h + a2[1]; } }
        hin[dir * 64 + c] = h; }
    __syncthreads();
    const int t = C.tid >> 1, c0 = 32 * (C.tid & 1), chg = 64 * cg + c0, tl = segl * 256 + t, m = MCTX + tl;
    const bf16* PROJ = (const bf16*)(WSP + WS_PROJ);
    const v4u* gp = (const v4u*)(PROJ + (size_t)m * pg8::PROJ_LD + 1280 + chg); bf16* yp = (bf16*)(WSP + WS_XN) + (size_t)m * 1024 + 256 + chg;
    const float* hp = (const float*)(WSP + WS_RGH) + (size_t)tl * 256 + chg;
    const v4u* pf = (const v4u*)((const bf16*)(WSP + WS_RGP) + (size_t)tl * 256 + chg); const v4u* pb = (const v4u*)((const bf16*)(WSP + WS_RGP) + (size_t)(8192 + tl) * 256 + chg);
#pragma unroll
    for (int q = 0; q < 4; ++q) { const v4u gv = gp[q], fv = pf[q], bv = pb[q]; const f32x4 h0 = *(const f32x4*)(hp + 8 * q), h1 = *(const f32x4*)(hp + 8 * q + 4);
        const LAS float* hf = hin + c0 + 8 * q; const LAS float* hbk = hin + 64 + c0 + 8 * q;
        float hv[8];
        hv[0] = h0.x + bflo(fv.x) * hf[0] + bflo(bv.x) * hbk[0]; hv[1] = h0.y + bfhi(fv.x) * hf[1] + bfhi(bv.x) * hbk[1];
        hv[2] = h0.z + bflo(fv.y) * hf[2] + bflo(bv.y) * hbk[2]; hv[3] = h0.w + bfhi(fv.y) * hf[3] + bfhi(bv.y) * hbk[3];
        hv[4] = h1.x + bflo(fv.z) * hf[4] + bflo(bv.z) * hbk[4]; hv[5] = h1.y + bfhi(fv.z) * hf[5] + bfhi(bv.z) * hbk[5];
        hv[6] = h1.z + bflo(fv.w) * hf[6] + bflo(bv.w) * hbk[6]; hv[7] = h1.w + bfhi(fv.w) * hf[7] + bfhi(bv.w) * hbk[7];
        v4u o; o.x = pk2(hv[0] * gelu_tanh(bflo(gv.x)), hv[1] * gelu_tanh(bfhi(gv.x))); o.y = pk2(hv[2] * gelu_tanh(bflo(gv.y)), hv[3] * gelu_tanh(bfhi(gv.y)));
        o.z = pk2(hv[4] * gelu_tanh(bflo(gv.z)), hv[5] * gelu_tanh(bfhi(gv.z))); o.w = pk2(hv[6] * gelu_tanh(bflo(gv.w)), hv[7] * gelu_tanh(bfhi(gv.w)));
        *(GAS v4u*)(yp + 8 * q) = o; }
}
typedef short s16x4 __attribute__((ext_vector_type(4)));
template <int CTRL> __device__ __forceinline__ float dpp_mov_id1(float x) { return __builtin_bit_cast(float, __builtin_amdgcn_update_dpp(0x3f800000, __builtin_bit_cast(int, x), CTRL, 0xf, 0xf, false)); }
__device__ __forceinline__ float row_cumprod16(float x) { x *= dpp_mov_id1<0x111>(x); x *= dpp_mov_id1<0x112>(x); x *= dpp_mov_id1<0x114>(x); x *= dpp_mov_id1<0x118>(x); return x; }
__device__ __forceinline__ s16x4 pack_bf16x4(float a, float b, float c, float d) { return __builtin_bit_cast(s16x4, pk4(a, b, c, d)); }
__device__ __forceinline__ bf16x8 pack_bf16x8s(float a0, float a1, float a2, float a3, float a4, float a5, float a6, float a7) {
    return __builtin_bit_cast(bf16x8, pk8(a0, a1, a2, a3, a4, a5, a6, a7)); }

#define GLA_LOAD_RAW(R, cidx) do { const int ts_ = dir ? 255 - (16 * (cidx) + tt) : 16 * (cidx) + tt; const bf16* row_ = PROJ + (size_t)(m0 + ts_) * pg8::PROJ_LD; \
        _Pragma("unroll") for (int i_ = 0; i_ < 4; ++i_) { R.k[i_] = *(const v2u*)(row_ + kcol + hc + 16 * i_ + 4 * g); } \
        R.v0 = *(const v4u*)(row_ + vcol + hc + 16 * g); R.v1 = *(const v4u*)(row_ + vcol + hc + 16 * g + 8); if (mixer == 0) R.lr = *(const v2u*)(row_ + 2816 + 4 * g); } while (0)
struct GlaRaw { v2u k[4]; v4u v0, v1; v2u lr; };
template <bool MAIN, int mixer>
__device__ __forceinline__ void gla3_unit(const Ctx& C, int l, int seg, int head_arg) {
    if (MAIN && C.wave >= 4) { __syncthreads(); __syncthreads(); return; }
    const int head = MAIN ? 2 * head_arg + ((C.wave >> 1) & 1) : head_arg, dir = MAIN ? (C.wave & 1) : (C.wave >> 2), quarter = C.wave & 3;
    const int lane = C.lane, tt = lane & 15, g = lane >> 4;
    LAS bf16* Vt = (LAS bf16*)(C.lds + C.wave * 5376); LAS bf16* Kt = Vt + 16 * 80; LAS float* ctab = (LAS float*)(Kt + 16 * 80);
    const bool lat = seg >= 32; const int m0 = seg * 256, hc = 64 * head;
    const bf16* PROJ = (const bf16*)(WSP + WS_PROJ);
    s16x4 WgA[4];
#pragma unroll
    for (int i = 0; i < 4; ++i) WgA[i] = (s16x4){0, 0, 0, 0};
    if (mixer == 0) {
        const float* wg = INP(I_GLAWG) + (size_t)(l * 2 + dir) * 16 * 256 + hc;
#pragma unroll
        for (int i = 0; i < 4; ++i) WgA[i] = pack_bf16x4(wg[(4 * g + 0) * 256 + 16 * i + tt], wg[(4 * g + 1) * 256 + 16 * i + tt], wg[(4 * g + 2) * 256 + 16 * i + tt], wg[(4 * g + 3) * 256 + 16 * i + tt]);
        ctab[lane] = INP(I_GLABG)[(l * 2 + dir) * 256 + hc + lane];
    } else ctab[lane] = (l > 0) ? sigmoidf_(INP(I_HGLOW)[256 + hc + lane] - INP(I_HGLOW)[hc + lane]) : 0.f;
    f32x4 S[4][4];
    const unsigned soff0 = (unsigned)((4 * g) * 64 + tt);
#pragma unroll
    for (int kt = 0; kt < 4; ++kt)
#pragma unroll
        for (int vt = 0; vt < 4; ++vt) S[kt][vt] = (f32x4){0.f, 0.f, 0.f, 0.f};
    if (MAIN && lat) {
        const int segl = seg - 32, b = segl >> 4, jseg = segl & 15;
        const float* st = INP(mixer ? I_SHG : I_SGLA) + ((size_t)(((b * 2 + l) * 2 + dir) * 4 + head) * 64) * 64;
#pragma unroll
        for (int kt = 0; kt < 4; ++kt)
#pragma unroll
            for (int r = 0; r < 4; ++r) { unsigned o = soff0 + (unsigned)((16 * kt + r) * 64); asm volatile("" : "+v"(o) :: "memory");
#pragma unroll
                for (int vt = 0; vt < 4; ++vt) S[kt][vt][r] = st[o + 16 * vt]; }
        const float* GS = (const float*)(WSP + WS_GS); const float* GD = (const float*)(WSP + WS_GD);
        const int i0 = dir ? 15 : 0, di = dir ? -1 : 1;
#pragma unroll 1
        for (int i = i0; i != jseg; i += di) { const size_t ub = (size_t)((((b * 16 + i) * 2 + mixer) * 4 + head) * 2 + dir) * 64;
            const float* GSu = GS + ub * 64;
#pragma unroll
            for (int kt = 0; kt < 4; ++kt) { const f32x4 dv = *(const f32x4*)(GD + ub + 16 * kt + 4 * g);
#pragma unroll
                for (int r = 0; r < 4; ++r) { unsigned o = soff0 + (unsigned)((16 * kt + r) * 64); asm volatile("" : "+v"(o) :: "memory");
#pragma unroll
                    for (int vt = 0; vt < 4; ++vt) S[kt][vt][r] = dv[r] * S[kt][vt][r] + GSu[o + 16 * vt]; } } }
    }
    float dtot[4][4];
#pragma unroll
    for (int i = 0; i < 4; ++i)
#pragma unroll
        for (int e = 0; e < 4; ++e) dtot[i][e] = 1.f;
    const int qcol = mixer ? 1536 : 0, kcol = mixer ? (dir ? 2048 : 1792) : 256, vcol = mixer ? 2304 : 512, gcol = mixer ? 2560 : 768, ycol = mixer ? 768 : 0;
    float* OS = (float*)(WSP + WS_OSUM) + 256 * mixer + hc;
    bf16* Yb = (bf16*)(WSP + WS_XN) + ycol + hc;
    f32x4 gnv = (f32x4){0.f, 0.f, 0.f, 0.f};
    if (MAIN) { const float* gn = INP(mixer ? I_HGNG : I_GLANG) + l * 256 + hc + tt; gnv = (f32x4){gn[0], gn[16], gn[32], gn[48]}; }
    const int trq = tt >> 2, trp = tt & 3;
    constexpr int NCH = MAIN ? 16 : 4; const int cbase = MAIN ? 0 : 4 * quarter;
    GlaRaw cur; GLA_LOAD_RAW(cur, cbase);
#pragma unroll 1
    for (int ci = 0; ci < NCH; ++ci) {
        const int c = cbase + ci;
        GlaRaw nxt; { const int cn = cbase + (ci + 1 < NCH ? ci + 1 : ci); GLA_LOAD_RAW(nxt, cn); }
        if (MAIN && ci == 8) { VM_WAIT(); __syncthreads(); }
        *(LAS v4u*)(Vt + tt * 80 + 16 * g) = cur.v0; *(LAS v4u*)(Vt + tt * 80 + 16 * g + 8) = cur.v1;
        v2u qraw[4];
        if (MAIN) { const int ts_ = dir ? 255 - (16 * c + tt) : 16 * c + tt; const bf16* row_ = PROJ + (size_t)(m0 + ts_) * pg8::PROJ_LD;
#pragma unroll
            for (int i = 0; i < 4; ++i) qraw[i] = *(const v2u*)(row_ + qcol + hc + 16 * i + 4 * g); }
        float a[4][4], kk[4][4], qq[4][4];
        if (mixer == 0) {
            const s16x4 lrb = __builtin_bit_cast(s16x4, cur.lr);
#pragma unroll
            for (int i = 0; i < 4; ++i) { const f32x4 x = __builtin_amdgcn_mfma_f32_16x16x16bf16_1k(WgA[i], lrb, *(const LAS f32x4*)(ctab + 16 * i + 4 * g), 0, 0, 0);
#pragma unroll
                for (int e = 0; e < 4; ++e) { const float xe = fmaxf(x[e], -60.f); a[i][e] = __builtin_amdgcn_exp2f(-0.0625f * __builtin_amdgcn_logf(1.f + __expf(-xe))); }
                kk[i][0] = bflo(cur.k[i].x); kk[i][1] = bfhi(cur.k[i].x); kk[i][2] = bflo(cur.k[i].y); kk[i][3] = bfhi(cur.k[i].y);
                if (MAIN) { qq[i][0] = 0.125f * bflo(qraw[i].x); qq[i][1] = 0.125f * bfhi(qraw[i].x); qq[i][2] = 0.125f * bflo(qraw[i].y); qq[i][3] = 0.125f * bfhi(qraw[i].y); } }
        } else {
#pragma unroll
            for (int i = 0; i < 4; ++i) { float fl[4] = {bflo(cur.k[i].x), bfhi(cur.k[i].x), bflo(cur.k[i].y), bfhi(cur.k[i].y)}; const f32x4 lbq = *(const LAS f32x4*)(ctab + 16 * i + 4 * g);
#pragma unroll
                for (int e = 0; e < 4; ++e) { const float ef = __expf(-fmaxf(fl[e], -80.f)); const float sg = __builtin_amdgcn_rcpf(1.f + ef); const float sn = ef * sg;
                    a[i][e] = lbq[e] + (1.f - lbq[e]) * sg; kk[i][e] = (1.f - lbq[e]) * sn; }
                if (MAIN) { float dq[4] = {bflo(qraw[i].x), bfhi(qraw[i].x), bflo(qraw[i].y), bfhi(qraw[i].y)};
#pragma unroll
                    for (int e = 0; e < 4; ++e) qq[i][e] = dq[e] * __builtin_amdgcn_rcpf(1.f + __expf(-dq[e])); } }
        }
        float Aend[4][4]; bf16x8 qf[2], kf[2];
#pragma unroll
        for (int i = 0; i < 4; ++i) { float qh[4], kh_[4], kt_[4];
#pragma unroll
            for (int e = 0; e < 4; ++e) { const float A = row_cumprod16(a[i][e]); Aend[i][e] = __shfl(A, (lane & 48) | 15); const float rA = __builtin_amdgcn_rcpf(A);
                kh_[e] = kk[i][e] * rA; kt_[e] = kh_[e] * Aend[i][e]; if (MAIN) qh[e] = qq[i][e] * A; if (!MAIN) dtot[i][e] *= Aend[i][e]; }
            *(LAS s16x4*)(Kt + tt * 80 + 16 * i + 4 * g) = pack_bf16x4(kt_[0], kt_[1], kt_[2], kt_[3]);
            if (MAIN) { const v2u qw = __builtin_bit_cast(v2u, pack_bf16x4(qh[0], qh[1], qh[2], qh[3])), kw = __builtin_bit_cast(v2u, pack_bf16x4(kh_[0], kh_[1], kh_[2], kh_[3]));
                v4u tq = __builtin_bit_cast(v4u, qf[i >> 1]), tk = __builtin_bit_cast(v4u, kf[i >> 1]);
                if (i & 1) { tq.z = qw.x; tq.w = qw.y; tk.z = kw.x; tk.w = kw.y; } else { tq.x = qw.x; tq.y = qw.y; tk.x = kw.x; tk.y = kw.y; }
                qf[i >> 1] = __builtin_bit_cast(bf16x8, tq); kf[i >> 1] = __builtin_bit_cast(bf16x8, tk); } }
        float po[4][4]; unsigned short gz[4][4];
        if (MAIN && ci >= 8) {
#pragma unroll
            for (int r = 0; r < 4; ++r) { const int tr = 4 * g + r; const int tsr = dir ? 255 - (16 * c + tr) : 16 * c + tr; const unsigned mo = (unsigned)(m0 + tsr);
#pragma unroll
                for (int vt = 0; vt < 4; ++vt) { po[vt][r] = OS[mo * 512u + (unsigned)tt + 16u * vt]; gz[vt][r] = PROJ[mo * (unsigned)pg8::PROJ_LD + (unsigned)(gcol + hc + 16 * vt + tt)]; } }
        }
        s16x4 Vb[4], Kb[4];
#pragma unroll
        for (int t4 = 0; t4 < 4; ++t4) { Vb[t4] = __builtin_amdgcn_ds_read_tr16_b64_v4i16((LAS s16x4*)(Vt + (4 * g + trq) * 80 + 16 * t4 + 4 * trp));
                                           Kb[t4] = __builtin_amdgcn_ds_read_tr16_b64_v4i16((LAS s16x4*)(Kt + (4 * g + trq) * 80 + 16 * t4 + 4 * trp)); }
        if (MAIN) {
            f32x4 pa = (f32x4){0.f, 0.f, 0.f, 0.f};
            pa = __builtin_amdgcn_mfma_f32_16x16x32_bf16(kf[0], qf[0], pa, 0, 0, 0); pa = __builtin_amdgcn_mfma_f32_16x16x32_bf16(kf[1], qf[1], pa, 0, 0, 0);
            const s16x4 Pa = pack_bf16x4(4 * g + 0 <= tt ? pa[0] : 0.f, 4 * g + 1 <= tt ? pa[1] : 0.f, 4 * g + 2 <= tt ? pa[2] : 0.f, 4 * g + 3 <= tt ? pa[3] : 0.f);
            f32x4 ov[4];
#pragma unroll
            for (int vt = 0; vt < 4; ++vt) { f32x4 o = (f32x4){0.f, 0.f, 0.f, 0.f};
                const bf16x8 sb0 = pack_bf16x8s(S[0][vt][0], S[0][vt][1], S[0][vt][2], S[0][vt][3], S[1][vt][0], S[1][vt][1], S[1][vt][2], S[1][vt][3]);
                const bf16x8 sb1 = pack_bf16x8s(S[2][vt][0], S[2][vt][1], S[2][vt][2], S[2][vt][3], S[3][vt][0], S[3][vt][1], S[3][vt][2], S[3][vt][3]);
                    o = __builtin_amdgcn_mfma_f32_16x16x16bf16_1k(Pa, Vb[vt], o, 0, 0, 0);
                o = __builtin_amdgcn_mfma_f32_16x16x32_bf16(qf[0], sb0, o, 0, 0, 0); ov[vt] = __builtin_amdgcn_mfma_f32_16x16x32_bf16(qf[1], sb1, o, 0, 0, 0); }
            if (ci < 8) {
#pragma unroll
                for (int r = 0; r < 4; ++r) { const int tr = 4 * g + r; const int tsr = dir ? 255 - (16 * c + tr) : 16 * c + tr; const unsigned mo = (unsigned)(m0 + tsr);
#pragma unroll
                    for (int vt = 0; vt < 4; ++vt) OS[mo * 512u + (unsigned)tt + 16u * vt] = ov[vt][r]; }
            } else {
#pragma unroll
                for (int r = 0; r < 4; ++r) { float ss = 0.f;
#pragma unroll
                    for (int vt = 0; vt < 4; ++vt) { ov[vt][r] += po[vt][r]; ss += ov[vt][r] * ov[vt][r]; }
                    ss += __shfl_xor(ss, 1); ss += __shfl_xor(ss, 2); ss += __shfl_xor(ss, 4); ss += __shfl_xor(ss, 8);
                    const float rstd = 1.f / sqrtf(ss * (1.f / 64.f) + EPS);
                    const int tr = 4 * g + r; const int tsr = dir ? 255 - (16 * c + tr) : 16 * c + tr; const unsigned mo = (unsigned)(m0 + tsr);
#pragma unroll
                    for (int vt = 0; vt < 4; ++vt) { const float z = bf2f(gz[vt][r]); Yb[mo * 1024u + (unsigned)tt + 16u * vt] = (bf16)f2bf(ov[vt][r] * rstd * gnv[vt] * z * sigmoidf_(z)); } }
            }
        }
#pragma unroll
        for (int kt = 0; kt < 4; ++kt)
#pragma unroll
            for (int vt = 0; vt < 4; ++vt) { f32x4 s = S[kt][vt]; s[0] *= Aend[kt][0]; s[1] *= Aend[kt][1]; s[2] *= Aend[kt][2]; s[3] *= Aend[kt][3];
                S[kt][vt] = __builtin_amdgcn_mfma_f32_16x16x16bf16_1k(Kb[kt], Vb[vt], s, 0, 0, 0); }
        cur = nxt;
    }
    if (MAIN) {
        if (!lat) { float* so = OUTP + (mixer ? OUT_SHG : OUT_SGLA) + ((size_t)(((seg * 2 + l) * 2 + dir) * 4 + head) * 64) * 64;
#pragma unroll
            for (int kt = 0; kt < 4; ++kt)
#pragma unroll
                for (int r = 0; r < 4; ++r) { unsigned o = soff0 + (unsigned)((16 * kt + r) * 64); asm volatile("" : "+v"(o) :: "memory");
#pragma unroll
                    for (int vt = 0; vt < 4; ++vt) so[o + 16 * vt] = S[kt][vt][r]; } }
    } else {
        __syncthreads();
        LAS float* SP = (LAS float*)C.lds + C.wave * 4096; LAS float* DP = (LAS float*)C.lds + 8 * 4096 + C.wave * 64;
#pragma unroll
        for (int kt = 0; kt < 4; ++kt)
#pragma unroll
            for (int r = 0; r < 4; ++r)
#pragma unroll
                for (int vt = 0; vt < 4; ++vt) SP[soff0 + (16 * kt + r) * 64 + 16 * vt] = S[kt][vt][r];
        if (tt == 0) {
#pragma unroll
            for (int i = 0; i < 4; ++i) *(LAS f32x4*)(DP + 16 * i + 4 * g) = (f32x4){dtot[i][0], dtot[i][1], dtot[i][2], dtot[i][3]}; }
        __syncthreads();
        const int segl = seg - 32;
        const LAS float* SA = (const LAS float*)C.lds; const LAS float* DA = SA + 8 * 4096;
#pragma unroll 1
        for (int it = 0; it < 16; ++it) { const int e = C.tid + 512 * it, d = e >> 12, kv = e & 4095, k = kv >> 6;
            float sv = SA[(4 * d + 0) * 4096 + kv];
#pragma unroll
            for (int q = 1; q < 4; ++q) sv = sv * DA[(4 * d + q) * 64 + k] + SA[(4 * d + q) * 4096 + kv];
            ((float*)(WSP + WS_GS))[((size_t)(((segl * 2 + mixer) * 4 + head) * 2 + d) * 64) * 64 + kv] = sv; }
        if (C.tid < 128) { const int d = C.tid >> 6, k = C.tid & 63;
            ((float*)(WSP + WS_GD))[(size_t)(((segl * 2 + mixer) * 4 + head) * 2 + d) * 64 + k] = (DA[(4 * d) * 64 + k] * DA[(4 * d + 1) * 64 + k]) * (DA[(4 * d + 2) * 64 + k] * DA[(4 * d + 3) * 64 + k]); }
    }
    __syncthreads();
}
__device__ __forceinline__ int PIX(int i) { return i + (i >> 3); }
__device__ __forceinline__ f32x2 cmul(f32x2 a, f32x2 b) { return (f32x2){a.x * b.x - a.y * b.y, a.x * b.y + a.y * b.x}; }
__device__ __forceinline__ f32x2 cmulc(f32x2 a, f32x2 b) { return (f32x2){a.x * b.x + a.y * b.y, a.y * b.x - a.x * b.y}; }
template <bool INV> __device__ __forceinline__ f32x2 crot(f32x2 a) { return INV ? (f32x2){-a.y, a.x} : (f32x2){a.y, -a.x}; }
template <bool INV> __device__ __forceinline__ void dft8(f32x2 (&x)[8]) {
    const float h = 0.70710678118654752f;
    const f32x2 a0 = x[0] + x[4], a1 = x[0] - x[4], a2 = x[2] + x[6], a3 = crot<INV>(x[2] - x[6]);
    const f32x2 e0 = a0 + a2, e2 = a0 - a2, e1 = a1 + a3, e3 = a1 - a3;
    const f32x2 c0 = x[1] + x[5], c1 = x[1] - x[5], c2 = x[3] + x[7], c3 = crot<INV>(x[3] - x[7]);
    const f32x2 o0 = c0 + c2, o2r = c0 - c2, o1r = c1 + c3, o3r = c1 - c3;
    const f32x2 o1 = INV ? (f32x2){(o1r.x - o1r.y) * h, (o1r.y + o1r.x) * h} : (f32x2){(o1r.x + o1r.y) * h, (o1r.y - o1r.x) * h};
    const f32x2 o3 = INV ? (f32x2){-(o3r.x + o3r.y) * h, (o3r.x - o3r.y) * h} : (f32x2){(o3r.y - o3r.x) * h, -(o3r.x + o3r.y) * h};
    const f32x2 o2 = crot<INV>(o2r);
    x[0] = e0 + o0; x[1] = e1 + o1; x[2] = e2 + o2; x[3] = e3 + o3; x[4] = e0 - o0; x[5] = e1 - o1; x[6] = e2 - o2; x[7] = e3 - o3;
}
template <bool INV> __device__ __forceinline__ void dft16(f32x2 (&x)[16]) {
    f32x2 E[8], O[8];
#pragma unroll
    for (int k = 0; k < 8; ++k) { E[k] = x[2 * k]; O[k] = x[2 * k + 1]; }
    dft8<INV>(E); dft8<INV>(O);
    const float cs[8] = {1.f, 0.92387953251128674f, 0.70710678118654752f, 0.38268343236508977f, 0.f, -0.38268343236508977f, -0.70710678118654752f, -0.92387953251128674f};
    const float sn[8] = {0.f, 0.38268343236508977f, 0.70710678118654752f, 0.92387953251128674f, 1.f, 0.92387953251128674f, 0.70710678118654752f, 0.38268343236508977f};
#pragma unroll
    for (int k = 0; k < 8; ++k) { const f32x2 w = (f32x2){cs[k], INV ? sn[k] : -sn[k]}; const f32x2 o = cmul(O[k], w); x[k] = E[k] + o; x[k + 8] = E[k] - o; }
}
template <bool INV, int NC> __device__ __forceinline__ void fft_pass8(LAS f32x2* X, int tid) {
    constexpr int Q = NC / 8, ST = (NC == 512) ? 72 : (NC == 64) ? 9 : 1;
#pragma unroll 1
    for (int rep = 0; rep < 2; ++rep) { const int b = tid + 512 * rep, blk = b / Q, pos = b % Q, base = blk * NC + pos;
        LAS f32x2* Xb = X + PIX(base);
        f32x2 v[8];
#pragma unroll
        for (int q = 0; q < 8; ++q) v[q] = Xb[q * ST];
        f32x2 w1 = (f32x2){1.f, 0.f};
        if (NC > 8) { float s, c; sincospif((float)pos * (2.f / NC), &s, &c); w1 = (f32x2){c, -s}; }
        if (!INV) { dft8<false>(v);
            if (NC > 8) { f32x2 w = w1;
#pragma unroll
                for (int r = 1; r < 8; ++r) { v[r] = cmul(v[r], w); w = cmul(w, w1); } } }
        else { if (NC > 8) { f32x2 w = w1;
#pragma unroll
                for (int r = 1; r < 8; ++r) { v[r] = cmulc(v[r], w); w = cmul(w, w1); } }
            dft8<true>(v); }
#pragma unroll
        for (int q = 0; q < 8; ++q) Xb[q * ST] = v[q]; }
    __syncthreads();
}
template <bool INV> __device__ __forceinline__ void fft_pass16(LAS f32x2* X, int tid) {
    f32x2 v[16]; LAS f32x2* Xb = X + PIX(tid);
#pragma unroll
    for (int q = 0; q < 16; ++q) v[q] = Xb[576 * q];
    float s, c; sincospif((float)tid * (1.f / 4096.f), &s, &c); const f32x2 w1 = (f32x2){c, -s};
    if (!INV) { dft16<false>(v); f32x2 w = w1;
#pragma unroll
        for (int r = 1; r < 16; ++r) { v[r] = cmul(v[r], w); w = cmul(w, w1); } }
    else { f32x2 w = w1;
#pragma unroll
        for (int r = 1; r < 16; ++r) { v[r] = cmulc(v[r], w); w = cmul(w, w1); }
        dft16<true>(v); }
#pragma unroll
    for (int q = 0; q < 16; ++q) Xb[576 * q] = v[q];
    __syncthreads();
}
__device__ __forceinline__ void fft_fwd(LAS f32x2* x, int tid, bool lat) { if (lat) fft_pass16<false>(x, tid); fft_pass8<false, 512>(x, tid); fft_pass8<false, 64>(x, tid); fft_pass8<false, 8>(x, tid); }
__device__ __forceinline__ void fft_inv(LAS f32x2* x, int tid, bool lat) { fft_pass8<true, 8>(x, tid); fft_pass8<true, 64>(x, tid); fft_pass8<true, 512>(x, tid); if (lat) fft_pass16<true>(x, tid); }
template <int ORDER>
__device__ __forceinline__ void hy_unit(const Ctx& C, int l, int stream, int c) {
    LAS f32x2* x = (LAS f32x2*)C.lds; LAS v2u* ZG = (LAS v2u*)(x + 9216);
    const int f = ORDER * 256 + c; const bool lat = stream != 0;
    const int slen = stream ? 4096 : 256;
    const int zc = c, gc = (ORDER + 1) * 256 + c;
    __syncthreads();
    {   int tid = C.tid; asm volatile("" : "+v"(tid));
        LAS f32x2* xt = x + PIX(tid);
        if (stream) { const float* h = (const float*)(WSP + WS_HT) + ((size_t)l * 512 + f) * 4096;
#pragma unroll
            for (int i = 0; i < 8; ++i) { xt[576 * i] = (f32x2){h[(unsigned)(tid + 512 * i)], 0.f}; xt[576 * (i + 8)] = (f32x2){0.f, 0.f}; } }
        else { const float* h = (const float*)(WSP + WS_HTC) + ((size_t)l * 512 + f) * 256; const float hv = tid < 256 ? h[(unsigned)tid] : 0.f;
#pragma unroll
            for (int i = 0; i < 16; ++i) xt[576 * i] = (f32x2){hv, 0.f}; }
    }
    __syncthreads();
    fft_fwd(x, C.tid, lat);
    f32x2 H[16];
    {   LAS f32x2* xt = x + PIX(C.tid);
#pragma unroll
        for (int i = 0; i < 16; ++i) H[i] = xt[576 * i]; }
    __syncthreads();
    {   int tid = C.tid; asm volatile("" : "+v"(tid));
        LAS f32x2* xt = x + PIX(tid);
        const float* cw = INP(I_HYCW) + (size_t)l * 3 * 768; const float* cbp = INP(I_HYCB) + (size_t)l * 768;
        const float zw0 = cw[zc], zw1 = cw[768 + zc], zw2 = cw[1536 + zc], zb = cbp[zc];
        const float gw0 = cw[gc], gw1 = cw[768 + gc], gw2 = cw[1536 + gc], gb = cbp[gc];
        const bf16* CTv = (const bf16*)(WSP + WS_CT) + ((size_t)(c * 2 + stream) * 2) * 8192;
        const float* Z1 = (const float*)(WSP + WS_CT) + (size_t)c * 16384;
        const bool tval = stream ? true : (tid < 256);
#pragma unroll
        for (int i = 0; i < 16; ++i) {
            const bool valid = stream ? (i < 8) : tval;
            float zr = 0.f, zi = 0.f;
            if (valid) {
                const int pos = stream ? tid + 512 * i : tid;
                const unsigned mre = stream ? MCTX + pos : (2 * i) * 256 + pos, mim = mre + slen;
                const bool hasl = pos > 0, hasr = pos + 1 < slen;
                if (ORDER == 0) {
                    const bf16* v0 = CTv + (mre & 8191u); const bf16* v1 = CTv + (mim & 8191u);
                    zr = zb + zw1 * bf2f(v0[0]) + (hasl ? zw0 * bf2f(v0[-1]) : 0.f) + (hasr ? zw2 * bf2f(v0[1]) : 0.f);
                    zi = zb + zw1 * bf2f(v1[0]) + (hasl ? zw0 * bf2f(v1[-1]) : 0.f) + (hasr ? zw2 * bf2f(v1[1]) : 0.f);
                    const bf16* g0 = v0 + 8192; const bf16* g1 = v1 + 8192;
                    const float gr = gb + gw1 * bf2f(g0[0]) + (hasl ? gw0 * bf2f(g0[-1]) : 0.f) + (hasr ? gw2 * bf2f(g0[1]) : 0.f);
                    const float gi = gb + gw1 * bf2f(g1[0]) + (hasl ? gw0 * bf2f(g1[-1]) : 0.f) + (hasr ? gw2 * bf2f(g1[1]) : 0.f);
                    ZG[tid + 512 * i] = pk4(zr, zi, gr, gi);
                } else { zr = Z1[mre]; zi = Z1[mim]; }
            }
            xt[576 * i] = (f32x2){zr, zi};
        }
    }
    __syncthreads();
    fft_fwd(x, C.tid, lat);
    {   LAS f32x2* xt = x + PIX(C.tid);
#pragma unroll
        for (int i = 0; i < 16; ++i) { const f32x2 a = xt[576 * i]; xt[576 * i] = cmul(a, H[i]); } }
    __syncthreads();
    fft_inv(x, C.tid, lat);
    {   int tid2 = C.tid; asm volatile("" : "+v"(tid2));
        const float skip = INP(I_HYSKIP)[l * 512 + f];
        const float scale = stream ? (1.f / 8192.f) : (1.f / 512.f);
        const bool tval2 = stream ? true : (tid2 < 256);
        bf16* Yb = (bf16*)(WSP + WS_XN) + 512 + c; float* Z1 = (float*)(WSP + WS_CT) + (size_t)c * 16384;
        const bf16* CT2 = (const bf16*)(WSP + WS_CT2) + (size_t)c * 16384;
        const float* cw = INP(I_HYCW) + (size_t)l * 3 * 768; const float gw0 = cw[gc], gw1 = cw[768 + gc], gw2 = cw[1536 + gc], gb = INP(I_HYCB)[(size_t)l * 768 + gc];
        const LAS f32x2* xo = x + PIX(tid2) + (stream ? 2304 : 144);
#pragma unroll
        for (int i = 0; i < 16; ++i) {
            const bool valid = stream ? (i < 8) : tval2;
            if (valid) {
                const int pos = stream ? tid2 + 512 * i : tid2;
                const unsigned mre = stream ? MCTX + pos : (2 * i) * 256 + pos, mim = mre + slen;
                const f32x2 y = xo[576 * i];
                float zr, zi, gr, gi;
                if (ORDER == 0) { const v2u zz = ZG[tid2 + 512 * i]; zr = bflo(zz.x); zi = bfhi(zz.x); gr = bflo(zz.y); gi = bfhi(zz.y); }
                else { zr = Z1[mre]; zi = Z1[mim]; const bool hasl = pos > 0, hasr = pos + 1 < slen; const bf16* g0 = CT2 + mre; const bf16* g1 = CT2 + mim;
                    gr = gb + gw1 * bf2f(g0[0]) + (hasl ? gw0 * bf2f(g0[-1]) : 0.f) + (hasr ? gw2 * bf2f(g0[1]) : 0.f);
                    gi = gb + gw1 * bf2f(g1[0]) + (hasl ? gw0 * bf2f(g1[-1]) : 0.f) + (hasr ? gw2 * bf2f(g1[1]) : 0.f); }
                const float ore = gr * (y.x * scale + skip * zr), oim = gi * (y.y * scale + skip * zi);
                if (ORDER == 0) { Z1[mre] = ore; Z1[mim] = oim; }
                else { Yb[mre * 1024u] = (bf16)f2bf(ore); Yb[mim * 1024u] = (bf16)f2bf(oim); }
            }
        }
    }
    __syncthreads();
}
#ifndef PROBE_SUB
#define PROBE_SUB 0u
#endif
#ifndef PROBE_BLK
#define PROBE_BLK 0
#endif
#define SUB_T0(k) do { if ((PROBE_SUB >> (k)) & 1u) { __syncthreads(); tsub = __builtin_amdgcn_s_memrealtime(); } } while (0)
#define SUB_T1(k) do { if ((PROBE_SUB >> (k)) & 1u) { __syncthreads(); tacc += __builtin_amdgcn_s_memrealtime() - tsub; } } while (0)
__device__ __forceinline__ void mixers_pass1(const Ctx& C, int l, unsigned long long& tacc) {
    unsigned long long tsub = 0;
    SUB_T0(0);
    for (int rep = 0; rep < REP_RG; ++rep)
    for (int u = C.vcu; u < 256; u += C.G) rg_main(C, l, u);
    SUB_T1(0);
    __syncthreads();
    SUB_T0(1);
    for (int u = C.vcu; u < 256; u += C.G) { hy_unit<0>(C, l, 1, u); hy_unit<0>(C, l, 0, u); }
    SUB_T1(1);
    SUB_T0(2);
    for (int u = C.vcu; u < 256; u += C.G) { if (u & 4) gla3_unit<false, 1>(C, l, 32 + (u >> 3), u & 3); else gla3_unit<false, 0>(C, l, 32 + (u >> 3), u & 3); }
    SUB_T1(2);
}
__device__ __forceinline__ void mixers_pass2(const Ctx& C, int l, unsigned long long& tacc) {
    unsigned long long tsub = 0;
    SUB_T0(3);
    for (int u = C.vcu; u < 256; u += C.G) { if (u & 2) gla3_unit<true, 1>(C, l, u >> 2, u & 1); else gla3_unit<true, 0>(C, l, u >> 2, u & 1); }
    SUB_T1(3);
    __syncthreads();
    SUB_T0(4);
    for (int rep = 0; rep < REP_HY; ++rep)
    for (int u = C.vcu; u < 256; u += C.G) { hy_unit<1>(C, l, 1, u); hy_unit<1>(C, l, 0, u); }
    SUB_T1(4);
    SUB_T0(5);
    for (int u = C.vcu; u < 128; u += C.G) rg_corr(C, l, u);
    SUB_T1(5);
}
#ifndef PROBE_MASK
#define PROBE_MASK 0u
#endif
#define PH_T0(k) do { if ((PROBE_MASK >> (k)) & 1u) tph = __builtin_amdgcn_s_memrealtime(); } while (0)
#define PH_T1(k) do { if ((PROBE_MASK >> (k)) & 1u) tacc += __builtin_amdgcn_s_memrealtime() - tph; } while (0)
template <int l>
__device__ __forceinline__ void layer_phases(LAS unsigned char* ldsb, const int lo, const int hi, const XcdBarrier& bar, unsigned long long& tacc) {
    unsigned long long tph = 0;
#define IN(k) (lo <= (k) && (k) < hi)
#define SEAM(k) do { if (IN((k) + 1)) xcd_barrier(bar); } while (0)
    float* const modp = (float*)(WSP + WS_MOD);
    bf16* const XN = (bf16*)(WSP + WS_XN); bf16* const PROJ = (bf16*)(WSP + WS_PROJ);
        constexpr int pb = (l == 0) ? 2 : 10;
        const float* modl = modp + (size_t)l * 3 * 6144;
        if (IN(pb + 0)) {
            PH_T0(pb + 0);
            const Ctx C = make_ctx(ldsb);
            pg8::Gemm g{XN, (const bf16*)(WSP + WS_WIN), M, NIN, D}; pg8::StaticOrder S; S.init(M, NIN, C.G, (int)blockIdx.x);
            pg8::EpiProj E{PROJ, (bf16*)(WSP + WS_CT), (bf16*)(WSP + WS_CT2)};
            for (int rep = 0; rep < REP_GIN; ++rep)
            pg8::gemm_phase<pg8::EpiProj, pg8::StaticOrder, true, true>(C.lds, g, S, E);
            SEAM(pb + 0); PH_T1(pb + 0);
        }
        if (IN(pb + 1)) { PH_T0(pb + 1); const Ctx C = make_ctx(ldsb); mixers_pass1(C, l, tacc); SEAM(pb + 1); PH_T1(pb + 1); }
        if (IN(pb + 2)) { PH_T0(pb + 2); const Ctx C = make_ctx(ldsb); mixers_pass2(C, l, tacc); SEAM(pb + 2); PH_T1(pb + 2); }
        if (IN(pb + 3)) {
            PH_T0(pb + 3);
            const Ctx C = make_ctx(ldsb);
            pg8::Gemm g{XN, (const bf16*)(WSP + WS_WOUT), M, D, D}; pg8::StaticOrder S; S.init(M, D, C.G, (int)blockIdx.x);
            pg8::EpiResid E{OUTP, modl + 2048};
            pg8::gemm_phase<pg8::EpiResid, pg8::StaticOrder, true, true>(C.lds, g, S, E);
            SEAM(pb + 3); PH_T1(pb + 3);
        }
        if (IN(pb + 4)) { PH_T0(pb + 4); const Ctx C = make_ctx(ldsb); for (int rep = 0; rep < REP_NORM; ++rep) norm_rows<false>(C, INP(I_N2G) + l * D, modl, 3072, 4096); SEAM(pb + 4); PH_T1(pb + 4); }
        if (IN(pb + 5)) {
            PH_T0(pb + 5);
            const Ctx C = make_ctx(ldsb);
            pg8::Gemm g{XN, (const bf16*)(WSP + WS_W13), M, 2 * DFF, D}; pg8::StaticOrder S; S.init(M, 2 * DFF, C.G, (int)blockIdx.x);
            pg8::EpiSwiGLU E{PROJ, DFF};
            for (int rep = 0; rep < REP_GUP; ++rep)
            pg8::gemm_phase<pg8::EpiSwiGLU, pg8::StaticOrder, true, true>(C.lds, g, S, E);
            SEAM(pb + 5); PH_T1(pb + 5);
        }
        if (IN(pb + 6)) {
            PH_T0(pb + 6);
            const Ctx C = make_ctx(ldsb);
            pg8::Gemm g{PROJ, (const bf16*)(WSP + WS_W2), M, D, DFF}; pg8::StaticOrder S; S.init(M, D, C.G, (int)blockIdx.x);
            pg8::EpiResid E{OUTP, modl + 5120};
            pg8::gemm_phase<pg8::EpiResid, pg8::StaticOrder, true, true>(C.lds, g, S, E);
            SEAM(pb + 6); PH_T1(pb + 6);
        }
        if (l == 0 && IN(9)) { PH_T0(9); const Ctx C = make_ctx(ldsb); convert_weights(C, 1); norm_rows<false>(C, INP(I_N1G) + D, modp + 3 * 6144, 0, 1024); SEAM(9); PH_T1(9); }
#undef IN
#undef SEAM
}
struct Args { const float* in[N_IN]; float* out; unsigned char* ws; int ph_lo, ph_hi; };
constexpr int N_PHASES = 18;
__global__ void __launch_bounds__(NWAVES * 64, 2) mk_fwd(Args args) {
    extern __shared__ __attribute__((aligned(16))) unsigned char lds_raw[];
    LAS unsigned char* const ldsb = (LAS unsigned char*)lds_raw;
    volatile LAS unsigned* MISC = (volatile LAS unsigned*)(ldsb + MISC_OFF);
    for (int u = threadIdx.x; u < (LDS_BYTES - LDSCTL_OFF) / 4; u += NWAVES * 64) ((LAS unsigned*)(ldsb + LDSCTL_OFF))[u] = 0u;
    __syncthreads();
    const int lo = args.ph_lo, hi = args.ph_hi;
    const bool use_bar = (hi - lo) > 1;
    XcdBarrier bar; bar.bar = (unsigned*)(WSP + WS_CTL) + CW_BAR; bar.x = 0; bar.st = nullptr;
    if (use_bar) bar = xcd_barrier_post((unsigned*)(WSP + WS_CTL) + CW_BAR, MISC + 8);
#define IN(k) (lo <= (k) && (k) < hi)
#define SEAM(k) do { if (IN((k) + 1)) xcd_barrier(bar); } while (0)
    float* const modp = (float*)(WSP + WS_MOD);
    bf16* const XN = (bf16*)(WSP + WS_XN); bf16* const PROJ = (bf16*)(WSP + WS_PROJ);

    unsigned long long tacc = 0, tph = 0;
    if (IN(0)) { PH_T0(0); const Ctx C = make_ctx(ldsb); for (int rep = 0; rep < REP_P0; ++rep) { p0_prologue(C); __syncthreads(); } SEAM(0); PH_T1(0); }
    if (IN(1)) { PH_T0(1); const Ctx C = make_ctx(ldsb); for (int rep = 0; rep < REP_P1; ++rep) { norm_rows<true>(C, INP(I_N1G), modp, 0, 1024); hyena_filters(C); __syncthreads(); } SEAM(1); PH_T1(1); }
    layer_phases<0>(ldsb, lo, hi, bar, tacc);
    layer_phases<1>(ldsb, lo, hi, bar, tacc);
    if (IN(17)) { PH_T0(17); const Ctx C = make_ctx(ldsb); final_norm(C); PH_T1(17); }
    if ((PROBE_MASK != 0u || PROBE_SUB != 0u) && blockIdx.x == PROBE_BLK) { const unsigned long long te = __builtin_amdgcn_s_memrealtime(); while (__builtin_amdgcn_s_memrealtime() - te < tacc) __builtin_amdgcn_s_sleep(8); }
#undef IN
#undef SEAM
}

#ifndef MK_N_LAUNCHES
#define MK_N_LAUNCHES 1
#endif
extern "C" void kernel_launch(void* const* d_in, const int* in_sizes, int n_in, void* d_out, int out_size, void* d_ws, size_t ws_size, hipStream_t stream) {
    static int grid = 0;
    if (grid == 0) {
        if (n_in != N_IN || out_size != (int)OUT_END || ws_size < WS_END) { fprintf(stderr, "kernel_launch: unexpected sizes n_in %d out %d ws %zu\n", n_in, out_size, ws_size); grid = -1; return; }
        int dev = 0, cus = 0, per_cu = 0;
        if (hipGetDevice(&dev) != hipSuccess || hipDeviceGetAttribute(&cus, hipDeviceAttributeMultiprocessorCount, dev) != hipSuccess) { grid = -1; return; }
        if (hipFuncSetAttribute((const void*)mk_fwd, hipFuncAttributeMaxDynamicSharedMemorySize, LDS_BYTES) != hipSuccess) { fprintf(stderr, "kernel_launch: hipFuncSetAttribute failed\n"); grid = -1; return; }
        if (hipOccupancyMaxActiveBlocksPerMultiprocessor(&per_cu, (const void*)mk_fwd, NWAVES * 64, LDS_BYTES) != hipSuccess || per_cu < 1) { fprintf(stderr, "kernel_launch: occupancy query says %d blocks per CU\n", per_cu); per_cu = 1; }
        (void)hipGetLastError();
        grid = cus;
    }
    if (grid < 0) return;
    if (hipMemsetAsync((char*)d_ws + WS_CTL, 0, CTL_ZERO_BYTES, stream) != hipSuccess) { fprintf(stderr, "kernel_launch: memset failed\n"); return; }
    Args a{};
    for (int i = 0; i < N_IN; ++i) a.in[i] = (const float*)d_in[i];
    a.out = (float*)d_out; a.ws = (unsigned char*)d_ws;
#if MK_N_LAUNCHES == 1
    a.ph_lo = 0; a.ph_hi = N_PHASES;
    hipLaunchKernelGGL(mk_fwd, dim3(grid), dim3(NWAVES * 64), LDS_BYTES, stream, a);
#else
    for (int p = 0; p < N_PHASES; ++p) { a.ph_lo = p; a.ph_hi = p + 1; hipLaunchKernelGGL(mk_fwd, dim3(grid), dim3(NWAVES * 64), LDS_BYTES, stream, a); }
#endif
    const hipError_t le = hipPeekAtLastError();
    if (le != hipSuccess) fprintf(stderr, "kernel_launch: launch failed: %s\n", hipGetErrorName(le));
}
```

```cpp
#include <hip/hip_runtime.h>
#include <cstdio>
#include <cstdint>
#include <cmath>
namespace pg8 {
#define PG8_LAS __attribute__((address_space(3)))
typedef unsigned short bf16_t;
typedef short bf16x8 __attribute__((ext_vector_type(8)));
typedef float f32x4 __attribute__((ext_vector_type(4)));
typedef unsigned u32x4 __attribute__((ext_vector_type(4)));
constexpr int BM = 256, BK = 64, HALF = 128, HTB = HALF * BK * 2  , STAGE_BYTES = 8 * HTB, NXCD = 8, WGM = 8;

__host__ __device__ __forceinline__ int lds_byte(int r, int c) { const int st = (r >> 4) * 2 + (c >> 5), rr = r & 15, cc = c & 31, ob = rr * 64 + cc * 2; return st * 1024 + (ob ^ (((ob >> 9) & 1) << 5)); }
__host__ __device__ __forceinline__ void stage_rc(int b, int& R, int& C) { const int st = b / 1024, sb = b % 1024, swz = sb ^ (((sb >> 9) & 1) << 5); R = (st >> 1) * 16 + swz / 64; C = (st & 1) * 32 + (swz % 64) / 2; }
__host__ __device__ __forceinline__ int perm32(int rho) { const int n = rho >> 4, i = rho & 15; return 8 * (i >> 2) + 4 * n + (i & 3); }

struct Unit { int pm, pn; };
struct Gemm { const bf16_t* A; const bf16_t* Bt; int M, N, K; };

struct StaticOrder {
    int nM, nN, nwg, G, c;
    __host__ __device__ void init(int M, int N, int G_, int c_) { nM = M / BM; nN = N / BM; nwg = nM * nN; G = G_; c = c_; }
    __host__ __device__ bool next(int i, Unit& u) const {
        const long L = (long)i * G + c; if (L >= nwg) return false;
        int wgid = (int)L; { const int q = nwg / NXCD, r = nwg % NXCD, xcd = wgid % NXCD, off = wgid / NXCD; wgid = (xcd < r ? xcd * (q + 1) : r * (q + 1) + (xcd - r) * q) + off; }
        const int nig = WGM * nN, gid = wgid / nig, fm = gid * WGM, gsz = (nM - fm) < WGM ? (nM - fm) : WGM;
        u.pm = fm + ((wgid % nig) % gsz); u.pn = (wgid % nig) / gsz; return true;
    }
    __device__ __forceinline__ void a_ready(const Unit&) const {}
    __device__ __forceinline__ void done(const Unit&) const {}
};
__device__ __forceinline__ unsigned cvt_pk_bf16(float lo, float hi) { unsigned r; asm volatile("v_cvt_pk_bf16_f32 %0, %1, %2" : "=v"(r) : "v"(lo), "v"(hi)); return r; }
typedef float f32x2 __attribute__((ext_vector_type(2)));
constexpr int PROJ_LD = 2848;
struct EpiProj {
    static constexpr bool PERM = true, AFTER_DRAIN = false;
    bf16_t* PROJ; bf16_t* CT; bf16_t* CT2;
    __device__ __forceinline__ void operator()(const f32x4 (&acc)[2][2][4][2], const Unit& u, int wr, int wc, int fr, int fq) const {
        const int row0 = u.pm * BM + wr * 64 + fr;
        if (u.pn >= 3) {
            const bool lrt = (u.pn == 14);
            if (lrt && !(wc == 0 && fq < 2)) return;
            const unsigned voff0 = (unsigned)row0 * (unsigned)PROJ_LD + (unsigned)((u.pn - 3) * 256 + wc * 32 + 8 * fq);
#pragma unroll
            for (int ai = 0; ai < 2; ++ai)
#pragma unroll
                for (int m = 0; m < 4; ++m) { unsigned voff = voff0 + (unsigned)((ai * HALF + m * 16) * PROJ_LD); asm volatile("" : "+v"(voff));
#pragma unroll
                    for (int bj = 0; bj < 2; ++bj) { if (lrt && bj == 1) continue;
                        const f32x4 v0 = acc[ai][bj][m][0], v1 = acc[ai][bj][m][1];
                        u32x4 w; w.x = cvt_pk_bf16(v0[0], v0[1]); w.y = cvt_pk_bf16(v0[2], v0[3]); w.z = cvt_pk_bf16(v1[0], v1[1]); w.w = cvt_pk_bf16(v1[2], v1[3]);
                        *(u32x4*)(PROJ + voff + bj * HALF) = w; } }
        } else {
            bf16_t* base = (u.pn == 0) ? CT : (u.pn == 1) ? CT + 8192 : CT2;
            const unsigned cs = (u.pn == 2) ? 16384u : 32768u;
            const unsigned rofs = (u.pn == 2) ? (unsigned)row0 : ((unsigned)(row0 & 8191) + ((row0 >> 13) ? 16384u : 0u));
            const unsigned voff0 = (unsigned)(wc * 32 + 8 * fq) * cs + rofs;
#pragma unroll
            for (int bj = 0; bj < 2; ++bj)
#pragma unroll
                for (int n = 0; n < 2; ++n)
#pragma unroll
                    for (int e = 0; e < 4; e += 2) { unsigned voff = voff0 + (unsigned)(bj * HALF + 4 * n + e) * cs; asm volatile("" : "+v"(voff)); unsigned voff1 = voff + cs; asm volatile("" : "+v"(voff1));
#pragma unroll
                        for (int ai = 0; ai < 2; ++ai)
#pragma unroll
                            for (int m = 0; m < 4; ++m) { const unsigned w = cvt_pk_bf16(acc[ai][bj][m][n][e], acc[ai][bj][m][n][e + 1]);
                                base[voff + ai * HALF + m * 16] = (bf16_t)(w & 0xffffu); base[voff1 + ai * HALF + m * 16] = (bf16_t)(w >> 16); }
                        asm volatile("" ::: "memory"); }
        }
    }
};
struct EpiResid {
    static constexpr bool PERM = false, AFTER_DRAIN = false;
    float* X; const float* gate3;
    __device__ __forceinline__ void operator()(const f32x4 (&acc)[2][2][4][2], const Unit& u, int wr, int wc, int fr, int fq) const {
        const int r = (u.pm < 32) ? 0 : 1 + ((u.pm - 32) >> 4);
        const float* g = gate3 + r * 6144;
        const int col0 = u.pn * BM + wc * 32 + 4 * fq;
        f32x4 gv[2][2];
#pragma unroll
        for (int bj = 0; bj < 2; ++bj)
#pragma unroll
            for (int n = 0; n < 2; ++n) gv[bj][n] = *(const f32x4*)(g + col0 + bj * HALF + n * 16);
#pragma unroll
        for (int ai = 0; ai < 2; ++ai)
#pragma unroll
            for (int m = 0; m < 4; ++m) { float* rowp = X + (size_t)(u.pm * BM + ai * HALF + wr * 64 + m * 16 + fr) * 1024 + col0;
#pragma unroll
                for (int bj = 0; bj < 2; ++bj)
#pragma unroll
                    for (int n = 0; n < 2; ++n) { f32x4* p = (f32x4*)(rowp + bj * HALF + n * 16); const f32x4 x = *p; *p = x + gv[bj][n] * acc[ai][bj][m][n]; } }
    }
};
struct EpiSwiGLU {
    static constexpr bool PERM = true, AFTER_DRAIN = false;
    bf16_t* HID; int ldh;
    __device__ __forceinline__ void operator()(const f32x4 (&acc)[2][2][4][2], const Unit& u, int wr, int wc, int fr, int fq) const {
        const int row0 = u.pm * BM + wr * 64 + fr, col0 = u.pn * HALF + wc * 32 + 8 * fq;
#pragma unroll
        for (int ai = 0; ai < 2; ++ai)
#pragma unroll
            for (int m = 0; m < 4; ++m) { float h[8];
#pragma unroll
                for (int n = 0; n < 2; ++n)
#pragma unroll
                    for (int e = 0; e < 4; ++e) { const float a = acc[ai][0][m][n][e], b = acc[ai][1][m][n][e]; h[4 * n + e] = a * b * __builtin_amdgcn_rcpf(1.f + __expf(-a)); }
                u32x4 w; w.x = cvt_pk_bf16(h[0], h[1]); w.y = cvt_pk_bf16(h[2], h[3]); w.z = cvt_pk_bf16(h[4], h[5]); w.w = cvt_pk_bf16(h[6], h[7]);
                *(u32x4*)(HID + (size_t)(row0 + ai * HALF + m * 16) * ldh + col0) = w; }
    }
};
template <class Epi, class Sched, bool ALIGN_EPI = false, bool SP2 = false>
__device__ __forceinline__ void gemm_phase(PG8_LAS unsigned char* lds, const Gemm g, const Sched& S, const Epi& E) {
    const int tid = threadIdx.x, wid = __builtin_amdgcn_readfirstlane(tid >> 6), lane = tid & 63, wr = wid >> 2, wc = wid & 3, fr = lane & 15, fq = lane >> 4;
    const int K = g.K, nt = K / BK;
    unsigned voffA[2], voffB[2];
#pragma unroll
    for (int i = 0; i < 2; ++i) { int R, C; stage_rc(tid * 16 + i * 8192, R, C); const int Rb = Epi::PERM ? ((R & ~31) + perm32(R & 31)) : R;
        voffA[i] = (unsigned)(R * K + C) * 2u; voffB[i] = (unsigned)(Rb * K + C) * 2u; }
    const size_t kstep = (size_t)(BK * 2);
    const size_t hstep = (size_t)HALF * K * 2;
    const size_t tstep = 2 * hstep;
    const unsigned ldsw = (unsigned)wid * 1024u;
    const int aoff = lds_byte(wr * 64 + fr, fq * 8), boff = lds_byte(wc * 32 + fr, fq * 8);
#define PG8_SA(b, h) (((b) * 2 + (h)) * HTB)
#define PG8_SB(b, h) ((4 + (b) * 2 + (h)) * HTB)
#define PG8_STAGE(bufoff, gbase, voff) do { _Pragma("unroll") for (int _i = 0; _i < 2; ++_i) \
        __builtin_amdgcn_global_load_lds((const unsigned*)((const char*)(gbase) + (voff)[_i]), (PG8_LAS unsigned*)(lds + (bufoff) + ldsw + _i * 8192), 16, 0, 0); } while (0)
#define PG8_LDA(dst, b, h) do { _Pragma("unroll") for (int m = 0; m < 4; ++m) _Pragma("unroll") for (int k = 0; k < 2; ++k) dst[m][k] = *(const PG8_LAS bf16x8*)(lds + PG8_SA(b, h) + aoff + m * 2048 + k * 1024); } while (0)
#define PG8_LDB(dst, b, h) do { _Pragma("unroll") for (int n = 0; n < 2; ++n) _Pragma("unroll") for (int k = 0; k < 2; ++k) dst[n][k] = *(const PG8_LAS bf16x8*)(lds + PG8_SB(b, h) + boff + n * 2048 + k * 1024); } while (0)
#define PG8_MMA(ai, bj, At, Bt) do { __builtin_amdgcn_s_setprio(1); _Pragma("unroll") for (int m = 0; m < 4; ++m) _Pragma("unroll") for (int n = 0; n < 2; ++n) _Pragma("unroll") for (int k = 0; k < 2; ++k) \
        acc[ai][bj][m][n] = __builtin_amdgcn_mfma_f32_16x16x32_bf16(Bt[n][k], At[m][k], acc[ai][bj][m][n], 0, 0, 0); __builtin_amdgcn_s_setprio(0); } while (0)
#define PG8_WAIT_V(n) asm volatile("s_waitcnt vmcnt(" #n ")" ::: "memory")
#define PG8_WAIT_L(n) asm volatile("s_waitcnt lgkmcnt(" #n ")" ::: "memory")
#define PG8_BAR __builtin_amdgcn_s_barrier()
#define PG8_SCHED __builtin_amdgcn_sched_barrier(0)
    Unit cur, nxt; int ui = 0;
    if (!S.next(0, cur)) return;
    f32x4 acc[2][2][4][2];
#pragma unroll
    for (int a = 0; a < 2; ++a)
#pragma unroll
        for (int b = 0; b < 2; ++b)
#pragma unroll
            for (int m = 0; m < 4; ++m)
#pragma unroll
                for (int n = 0; n < 2; ++n) acc[a][b][m][n] = (f32x4){0.f, 0.f, 0.f, 0.f};
    bf16x8 At[4][2], B0[2][2], B1[2][2];
    const char* cA = (const char*)g.A + (size_t)cur.pm * tstep; const char* cB = (const char*)g.Bt + (size_t)cur.pn * tstep;
    S.a_ready(cur);
    if constexpr (SP2) {
        PG8_STAGE(PG8_SB(0, 0), cB, voffB); PG8_STAGE(PG8_SB(0, 1), cB + hstep, voffB); PG8_STAGE(PG8_SA(0, 0), cA, voffA); PG8_STAGE(PG8_SA(0, 1), cA + hstep, voffA);
        if (wr == 1) PG8_BAR;
        PG8_WAIT_V(2); PG8_BAR;
        PG8_STAGE(PG8_SB(1, 0), cB + kstep, voffB); PG8_STAGE(PG8_SA(1, 0), cA + kstep, voffA); PG8_STAGE(PG8_SB(1, 1), cB + hstep + kstep, voffB);
        PG8_WAIT_V(6); PG8_BAR;
    } else {
        PG8_STAGE(PG8_SB(0, 0), cB, voffB); PG8_STAGE(PG8_SA(0, 0), cA, voffA); PG8_STAGE(PG8_SB(0, 1), cB + hstep, voffB); PG8_STAGE(PG8_SA(0, 1), cA + hstep, voffA);
        if (wr == 1) PG8_BAR;
        PG8_WAIT_V(4); PG8_BAR;
        PG8_STAGE(PG8_SB(1, 0), cB + kstep, voffB); PG8_STAGE(PG8_SA(1, 0), cA + kstep, voffA); PG8_STAGE(PG8_SB(1, 1), cB + hstep + kstep, voffB);
        PG8_WAIT_V(6); PG8_BAR;
    }
    for (;;) {
        const bool has_next = S.next(ui + 1, nxt);
        const char* nA = has_next ? (const char*)g.A + (size_t)nxt.pm * tstep : cA; const char* nB = has_next ? (const char*)g.Bt + (size_t)nxt.pn * tstep : cB;
        for (int t = 0; t < nt; t += 2) {
            const bool last = (t == nt - 2);
            const char* a1 = cA + (size_t)(t + 1) * kstep;
            const char* a2 = last ? nA : cA + (size_t)(t + 2) * kstep; const char* b2 = last ? nB : cB + (size_t)(t + 2) * kstep;
            const char* a3 = a2 + kstep; const char* b3 = b2 + kstep;
            if (last && has_next) S.a_ready(nxt);
            if constexpr (SP2) {
            PG8_LDB(B0, 0, 0); PG8_LDB(B1, 0, 1); PG8_SCHED; PG8_LDA(At, 0, 0); PG8_STAGE(PG8_SA(1, 1), a1 + hstep, voffA);
            PG8_WAIT_V(8); PG8_WAIT_L(0); PG8_BAR; PG8_MMA(0, 0, At, B0); PG8_MMA(0, 1, At, B1); PG8_BAR; PG8_SCHED;
            PG8_LDA(At, 0, 1); PG8_STAGE(PG8_SB(0, 0), b2, voffB); PG8_STAGE(PG8_SB(0, 1), b2 + hstep, voffB); PG8_STAGE(PG8_SA(0, 0), a2, voffA);
            PG8_WAIT_V(8); PG8_WAIT_L(0); PG8_BAR; PG8_MMA(1, 0, At, B0); PG8_MMA(1, 1, At, B1); PG8_BAR; PG8_SCHED;
            PG8_LDB(B0, 1, 0); PG8_LDB(B1, 1, 1); PG8_SCHED; PG8_LDA(At, 1, 0); PG8_STAGE(PG8_SA(0, 1), a2 + hstep, voffA);
            PG8_WAIT_V(8); PG8_WAIT_L(0); PG8_BAR; PG8_MMA(0, 0, At, B0); PG8_MMA(0, 1, At, B1); PG8_BAR; PG8_SCHED;
            PG8_LDA(At, 1, 1); PG8_STAGE(PG8_SB(1, 0), b3, voffB); PG8_STAGE(PG8_SB(1, 1), b3 + hstep, voffB); PG8_STAGE(PG8_SA(1, 0), a3, voffA);
            PG8_WAIT_V(8); PG8_WAIT_L(0); PG8_BAR; PG8_MMA(1, 0, At, B0); PG8_MMA(1, 1, At, B1); PG8_BAR; PG8_SCHED;
            } else {
            PG8_LDB(B0, 0, 0); PG8_SCHED; PG8_LDA(At, 0, 0); PG8_STAGE(PG8_SA(1, 1), a1 + hstep, voffA);
            PG8_WAIT_L(8); PG8_BAR; PG8_WAIT_L(0); PG8_MMA(0, 0, At, B0); PG8_BAR; PG8_SCHED;
            PG8_LDB(B1, 0, 1); PG8_STAGE(PG8_SB(0, 0), b2, voffB);
            PG8_BAR; PG8_WAIT_L(0); PG8_MMA(0, 1, At, B1); PG8_BAR;
            PG8_LDA(At, 0, 1); PG8_STAGE(PG8_SA(0, 0), a2, voffA);
            PG8_BAR; PG8_WAIT_L(0); PG8_MMA(1, 0, At, B0); PG8_BAR; PG8_SCHED;
            PG8_STAGE(PG8_SB(0, 1), b2 + hstep, voffB);
            PG8_WAIT_V(6); PG8_BAR; PG8_MMA(1, 1, At, B1); PG8_BAR;
            PG8_LDB(B0, 1, 0); PG8_SCHED; PG8_LDA(At, 1, 0); PG8_STAGE(PG8_SA(0, 1), a2 + hstep, voffA);
            PG8_WAIT_L(8); PG8_BAR; PG8_WAIT_L(0); PG8_MMA(0, 0, At, B0); PG8_BAR; PG8_SCHED;
            PG8_LDB(B1, 1, 1); PG8_STAGE(PG8_SB(1, 0), b3, voffB);
            PG8_BAR; PG8_WAIT_L(0); PG8_MMA(0, 1, At, B1); PG8_BAR;
            PG8_LDA(At, 1, 1); PG8_STAGE(PG8_SA(1, 0), a3, voffA);
            PG8_BAR; PG8_WAIT_L(0); PG8_MMA(1, 0, At, B0); PG8_BAR; PG8_SCHED;
            PG8_STAGE(PG8_SB(1, 1), b3 + hstep, voffB);
            PG8_WAIT_V(6); PG8_BAR; PG8_MMA(1, 1, At, B1); PG8_BAR;
            }
        }
        if constexpr (ALIGN_EPI) { if (wr == 0) PG8_BAR; }
        if constexpr (!Epi::AFTER_DRAIN) { E(acc, cur, wr, wc, fr, fq); S.done(cur); }
        if (!has_next) break;
#pragma unroll
        for (int a = 0; a < 2; ++a)
#pragma unroll
            for (int b = 0; b < 2; ++b)
#pragma unroll
                for (int m = 0; m < 4; ++m)
#pragma unroll
                    for (int n = 0; n < 2; ++n) acc[a][b][m][n] = (f32x4){0.f, 0.f, 0.f, 0.f};
        cur = nxt; cA = nA; cB = nB; ++ui;
        if constexpr (ALIGN_EPI) { if (wr == 1) PG8_BAR; }
    }
    PG8_WAIT_V(0);
    if constexpr (!ALIGN_EPI) { if (wr == 0) PG8_BAR; }
    PG8_BAR;
    if constexpr (Epi::AFTER_DRAIN) { E.fused(acc, cur, wr, wc, fr, fq, lds, wid, lane); S.done(cur); }
#undef PG8_SA
#undef PG8_SB
#undef PG8_STAGE
#undef PG8_LDA
#undef PG8_LDB
#undef PG8_MMA
#undef PG8_WAIT_V
#undef PG8_WAIT_L
#undef PG8_BAR
#undef PG8_SCHED
}
}
#ifndef REP_RG
#define REP_RG 1
#endif
#ifndef REP_AGG
#define REP_AGG 1
#endif
#ifndef REP_HY
#define REP_HY 1
#endif
#ifndef REP_GIN
#define REP_GIN 1
#endif
#ifndef REP_GUP
#define REP_GUP 1
#endif
#ifndef REP_NORM
#define REP_NORM 1
#endif
#ifndef REP_P0
#define REP_P0 1
#endif
#ifndef REP_P1
#define REP_P1 1
#endif
constexpr int NWAVES = 8;
constexpr int D = 1024, M = 16384, MCTX = 8192, DFF = 2816, NIN = 3840, DIN = 3600;
constexpr float EPS = 1e-6f;
constexpr size_t MiB = 1u << 20;
constexpr size_t WS_CTL = 0, CTL_ZERO_BYTES = MiB;
constexpr size_t WS_MOD = 512 * 1024;
constexpr size_t WS_SMALL = 1 * MiB;
constexpr size_t WS_PE = WS_SMALL + 147456;
constexpr size_t WS_RGW = WS_PE + 131072;
constexpr size_t WS_RGAGG = WS_RGW + 262144;
constexpr size_t WS_GD = WS_RGAGG + 131072;
static_assert(WS_GD + 131072 <= 2 * MiB, "small region");
constexpr size_t WS_H2 = 2 * MiB;
constexpr size_t WS_HT = 5 * MiB;
constexpr size_t WS_HTC = 21 * MiB;
constexpr size_t WS_WIN = 22 * MiB, WS_WOUT = WS_WIN + (size_t)NIN * D * 2, WS_W13 = WS_WOUT + (size_t)D * D * 2, WS_W2 = WS_W13 + (size_t)2 * DFF * D * 2;
static_assert(WS_W2 + (size_t)D * DFF * 2 == 48 * MiB, "weights fill [22,48) MiB");
constexpr size_t WS_XN = 48 * MiB;
constexpr size_t WS_PROJ = 80 * MiB;
constexpr size_t WS_CT = 169 * MiB, WS_CT2 = 185 * MiB;
constexpr size_t WS_OSUM = 193 * MiB;
constexpr size_t WS_RGH = 225 * MiB, WS_RGP = 233 * MiB;
constexpr size_t WS_GS = 241 * MiB, WS_END = 249 * MiB;
constexpr size_t OUT_YS = 8388608, OUT_SGLA = 16777216, OUT_SRG = 18874368, OUT_SHG = 18907136, OUT_END = 21004288;
constexpr int CW_BAR = 4096;
constexpr int RING_BYTES = 131072, LDS_BYTES = 147456, LDSCTL_OFF = LDS_BYTES - 512, MISC_OFF = LDSCTL_OFF + 320;

#define GAS __attribute__((address_space(1)))
#define LAS __attribute__((address_space(3)))
typedef unsigned short bf16;
typedef unsigned v4u __attribute__((ext_vector_type(4)));
typedef unsigned v2u __attribute__((ext_vector_type(2)));
typedef float f32x4 __attribute__((ext_vector_type(4)));
typedef float f32x2 __attribute__((ext_vector_type(2)));
typedef short bf16x8 __attribute__((ext_vector_type(8)));
typedef short bf16x4 __attribute__((ext_vector_type(4)));
typedef GAS unsigned gu32;
#define RLX_AGENT __ATOMIC_RELAXED, __HIP_MEMORY_SCOPE_AGENT
#define LDS_WAIT() asm volatile("s_waitcnt lgkmcnt(0)" ::: "memory")
#define VM_WAIT() asm volatile("s_waitcnt vmcnt(0)" ::: "memory")
__device__ __forceinline__ unsigned pk2(float lo, float hi) { return __builtin_amdgcn_perm(__builtin_bit_cast(unsigned, hi) + 0x8000u, __builtin_bit_cast(unsigned, lo) + 0x8000u, 0x07060302u); }
__device__ __forceinline__ v2u pk4(float a, float b, float c, float d) { v2u r; r.x = pk2(a, b); r.y = pk2(c, d); return r; }
__device__ __forceinline__ v4u pk8(float a0, float a1, float a2, float a3, float a4, float a5, float a6, float a7) { v4u r; r.x = pk2(a0, a1); r.y = pk2(a2, a3); r.z = pk2(a4, a5); r.w = pk2(a6, a7); return r; }
__device__ __forceinline__ unsigned f2bf(float f) { return (__builtin_bit_cast(unsigned, f) + 0x8000u) >> 16; }
__device__ __forceinline__ float bf2f(unsigned h) { return __builtin_bit_cast(float, h << 16); }
__device__ __forceinline__ float bflo(unsigned w) { return __builtin_bit_cast(float, w << 16); }
__device__ __forceinline__ float bfhi(unsigned w) { return __builtin_bit_cast(float, w & 0xffff0000u); }
__device__ __forceinline__ float wave_sum(float v) {
#pragma unroll
    for (int o = 1; o < 64; o <<= 1) v += __shfl_xor(v, o);
    return v;
}
__device__ __forceinline__ float sigmoidf_(float x) { return __builtin_amdgcn_rcpf(1.f + __expf(-x)); }
#define XB_TMO      128
#define XB_XCNT(j)  (256  + 64 * (j))
#define XB_XSUB(j)  (1280 + 64 * (j))
#define XB_XGEN(j)  (2304 + 64 * (j))
#define XB_TOP      3328
#define XB_TOPGEN   3392
#define XCD_BAR_WORDS 3456
#define XB_SPIN_CAP (1u << 18)

__device__ __forceinline__ unsigned xb_ld(unsigned* p)              { return __hip_atomic_load(p, __ATOMIC_RELAXED, __HIP_MEMORY_SCOPE_AGENT); }
__device__ __forceinline__ unsigned xb_add(unsigned* p, unsigned v) { return __hip_atomic_fetch_add(p, v, __ATOMIC_RELAXED, __HIP_MEMORY_SCOPE_AGENT); }
__device__ __forceinline__ unsigned xb_xcc_id() { return (unsigned)__builtin_amdgcn_s_getreg((3 << 11) | 20) & 0xFu; }
#define XB_SPIN(cond, bar) do { unsigned _sp = 0; while (cond) { __builtin_amdgcn_s_sleep(1); \
    if ((++_sp & 255u) == 0u) { if (xb_ld(&(bar)[XB_TMO])) break; if (_sp > XB_SPIN_CAP) { atomicAdd(&(bar)[XB_TMO], 1u); break; } } } } while (0)

struct XcdBarrier {
    unsigned* bar; unsigned x;
    volatile LAS unsigned* st;
};

__device__ __forceinline__ XcdBarrier xcd_barrier_post(unsigned* bar, volatile LAS unsigned* st) {
    XcdBarrier b; b.bar = bar; b.x = xb_xcc_id(); b.st = st;
    if (threadIdx.x == 0) (void)xb_add(&bar[XB_XCNT(b.x)], 1u);
    return b;
}
__device__ __forceinline__ void xcd_barrier_complete(unsigned* bar, unsigned x, unsigned& nloc, unsigned& nx) {
    const unsigned G = gridDim.x * gridDim.y * gridDim.z;
    unsigned sum, cnt, mine, sp = 0u;
    for (;;) {
        sum = 0u; cnt = 0u; mine = 0u;
#pragma unroll
        for (unsigned j = 0; j < 16; ++j) { const unsigned c = xb_ld(&bar[XB_XCNT(j)]); sum += c; cnt += (c > 0u) ? 1u : 0u; mine = (j == x) ? c : mine; }
        if (sum == G) break;
        __builtin_amdgcn_s_sleep(1);
        if ((++sp & 255u) == 0u) { if (xb_ld(&bar[XB_TMO])) break; if (sp > XB_SPIN_CAP) { atomicAdd(&bar[XB_TMO], 1u); break; } }
    }
    nloc = mine > 0u ? mine : 1u; nx = cnt > 0u ? cnt : 1u;
}

__device__ __forceinline__ void xcd_barrier(const XcdBarrier& b) {
    asm volatile("s_waitcnt vmcnt(0)" ::: "memory");
    __syncthreads();
    if (threadIdx.x == 0) {
        unsigned* bar = b.bar;
        __builtin_amdgcn_s_waitcnt(0);
        unsigned nloc = b.st[0], nx = b.st[1];
        if (nloc == 0u) { xcd_barrier_complete(bar, b.x, nloc, nx); b.st[0] = nloc; b.st[1] = nx; }
        const unsigned old = xb_add(&bar[XB_XSUB(b.x)], 1u);
        const unsigned gen = old / nloc;
        if (old + 1u == (gen + 1u) * nloc) {
            __builtin_amdgcn_fence(__ATOMIC_RELEASE, "agent");
            asm volatile("s_waitcnt vmcnt(0)" ::: "memory");
            const unsigned og = xb_add(&bar[XB_TOP], 1u);
            const unsigned tg = og / nx;
            if (og + 1u == (tg + 1u) * nx) xb_add(&bar[XB_TOPGEN], 1u);
            else XB_SPIN(xb_ld(&bar[XB_TOPGEN]) == tg, bar);
            __builtin_amdgcn_fence(__ATOMIC_ACQUIRE, "agent");
            xb_add(&bar[XB_XGEN(b.x)], 1u);
            asm volatile("s_waitcnt vmcnt(0)" ::: "memory");
        } else {
            XB_SPIN(xb_ld(&bar[XB_XGEN(b.x)]) == gen, bar);
            __builtin_amdgcn_fence(__ATOMIC_ACQUIRE, "agent");
            asm volatile("s_waitcnt vmcnt(0)" ::: "memory");
        }
    }
    __syncthreads();
}
struct Ctx { LAS unsigned char* lds; int tid, lane, wave, vcu, G; };
__device__ __forceinline__ Ctx make_ctx(LAS unsigned char* lds) {
    Ctx C; C.lds = lds; int t = threadIdx.x; asm volatile("" : "+v"(t)); C.tid = t; C.lane = t & 63; C.wave = __builtin_amdgcn_readfirstlane(t >> 6);
    C.G = gridDim.x; { const int bx = blockIdx.x; C.vcu = (C.G % 8 == 0) ? (bx % 8) * (C.G / 8) + bx / 8 : bx; }
    return C;
}
typedef const float* fptr_t;
#define KARG ((const __attribute__((address_space(4))) fptr_t*)__builtin_amdgcn_kernarg_segment_ptr())
#define INP(i) (KARG[(i)])
#define OUTP ((float*)KARG[N_IN])
#define WSP ((unsigned char*)KARG[N_IN + 1])
enum { I_XP = 0, I_XS, I_SGLA, I_SRG, I_SHG, I_C, I_CCTX, I_N1G, I_N2G, I_FNG, I_WMOD, I_BMOD, I_WIN, I_WOUT, I_GLAWG, I_GLABG, I_GLANG,
       I_RGCW, I_RGCB, I_RGWA, I_RGBA, I_RGWX, I_RGBX, I_RGLAM, I_HYCW, I_HYCB, I_HYW1, I_HYB1, I_HYW2, I_HYB2, I_HYW3, I_HYDEC, I_HYSKIP,
       I_HGLOW, I_HGNG, I_FW1, I_FW3, I_FW2, N_IN };

__device__ __forceinline__ void transpose_tile(const float* W, int ldw, int k0, int c0, int nvalid, bf16* WT, int ldt, int r0, LAS float* scr, int lane) {
    const int n_ = lane & 31;
    float tv[32];
    const float* Wp = W + (size_t)(k0 + (lane >> 5)) * ldw + c0 + n_;
#pragma unroll
    for (int i = 0; i < 32; ++i) tv[i] = (n_ < nvalid) ? Wp[(size_t)(2 * i) * ldw] : 0.f;
#pragma unroll
    for (int i = 0; i < 32; ++i) scr[(2 * i + (lane >> 5)) * 33 + n_] = tv[i];
    LDS_WAIT(); asm volatile("" ::: "memory");
    const int c = lane & 7;
#pragma unroll
    for (int j = 0; j < 4; ++j) { const int n = (lane >> 3) + 8 * j; const LAS float* s = scr + (8 * c) * 33 + n;
        const v4u o = pk8(s[0 * 33], s[1 * 33], s[2 * 33], s[3 * 33], s[4 * 33], s[5 * 33], s[6 * 33], s[7 * 33]);
        *(GAS v4u*)(WT + (size_t)(r0 + n) * ldt + k0 + 8 * c) = o; }
    LDS_WAIT(); asm volatile("" ::: "memory");
}
__device__ __forceinline__ void convert_weights(const Ctx& C, int l) {
    LAS float* scr = (LAS float*)(C.lds + C.wave * 16384);
    const int gw = C.vcu * NWAVES + C.wave, NGW = C.G * NWAVES;
    constexpr int I_IN = 16 * 120, I_OUT = 16 * 32, I_13 = 16 * 176, I_2 = 44 * 32, NITEMS = I_IN + I_OUT + I_13 + I_2;
    const float* win = INP(I_WIN) + (size_t)l * D * DIN; const float* wout = INP(I_WOUT) + (size_t)l * D * D;
    const float* w1 = INP(I_FW1) + (size_t)l * D * DFF; const float* w3 = INP(I_FW3) + (size_t)l * D * DFF; const float* w2 = INP(I_FW2) + (size_t)l * DFF * D;
    bf16* WinT = (bf16*)(WSP + WS_WIN); bf16* WoutT = (bf16*)(WSP + WS_WOUT); bf16* W13T = (bf16*)(WSP + WS_W13); bf16* W2T = (bf16*)(WSP + WS_W2);
    for (int it = gw; it < NITEMS; it += NGW) {
        int r = it;
        if (r < I_IN) { const int kb = r / 120, nb = r % 120, n0 = 32 * nb; int src, nv = 32;
            if (n0 < 768) src = 1552 + n0; else if (n0 < 1792) src = n0 - 768; else if (n0 < 2304) src = 1040 + (n0 - 1792); else if (n0 < 3584) src = 2320 + (n0 - 2304);
            else if (n0 == 3584) { src = 1024; nv = 16; } else { src = 0; nv = 0; }
            transpose_tile(win, DIN, 64 * kb, src, nv, WinT, D, n0, scr, C.lane); continue; } r -= I_IN;
        if (r < I_OUT) { const int kb = r / 32, nb = r % 32; transpose_tile(wout, D, 64 * kb, 32 * nb, 32, WoutT, D, 32 * nb, scr, C.lane); continue; } r -= I_OUT;
        if (r < I_13) { const int kb = r / 176, nb = r % 176, n0 = 32 * nb, tile = n0 >> 8, j = n0 & 255;
            transpose_tile(j < 128 ? w1 : w3, DFF, 64 * kb, 128 * tile + (j & 127), 32, W13T, D, n0, scr, C.lane); continue; } r -= I_13;
        { const int kb = r / 32, nb = r % 32; transpose_tile(w2, D, 64 * kb, 32 * nb, 32, W2T, DFF, 32 * nb, scr, C.lane); }
    }
}
__device__ __forceinline__ void mod_gemv(const Ctx& C) {
    LAS float* sc = (LAS float*)C.lds;
    for (int i = C.tid; i < 3072; i += NWAVES * 64) { const int r = i >> 10, k = i & 1023; const float v = (r == 0) ? INP(I_CCTX)[k] : INP(I_C)[(r - 1) * 1024 + k]; sc[i] = v * sigmoidf_(v); }
    __syncthreads();
    float* mod = (float*)(WSP + WS_MOD);
    const int gw = C.vcu * NWAVES + C.wave, NGW = C.G * NWAVES;
    for (int item = gw; item < 2 * 24 * 32; item += NGW) {
        const int kc = item & 31, cc = (item >> 5) % 24, l = item / (24 * 32), col = cc * 256 + 4 * C.lane;
        const float* w = INP(I_WMOD) + ((size_t)l * 1024 + kc * 32) * 6144 + col;
        f32x4 wv[32];
#pragma unroll
        for (int k = 0; k < 32; ++k) wv[k] = *(const f32x4*)(w + (size_t)k * 6144);
        f32x4 a0 = (f32x4){0.f, 0.f, 0.f, 0.f}, a1 = a0, a2 = a0;
#pragma unroll
        for (int k = 0; k < 32; ++k) { a0 += wv[k] * sc[kc * 32 + k]; a1 += wv[k] * sc[1024 + kc * 32 + k]; a2 += wv[k] * sc[2048 + kc * 32 + k]; }
        if (kc == 0) { const f32x4 b = *(const f32x4*)(INP(I_BMOD) + l * 6144 + col); a0 += b; a1 += b; a2 += b; }
        float* m0 = mod + ((size_t)l * 3) * 6144 + col;
#pragma unroll
        for (int e = 0; e < 4; ++e) { atomicAdd(m0 + e, a0[e]); atomicAdd(m0 + 6144 + e, a1[e]); atomicAdd(m0 + 2 * 6144 + e, a2[e]); }
    }
}
__device__ __forceinline__ void h2_rows(const Ctx& C) {
    const int gw = C.vcu * NWAVES + C.wave, NGW = C.G * NWAVES;
    float* H2 = (float*)(WSP + WS_H2);
    for (int rw = gw; rw < 2 * 4352; rw += NGW) {
        const int l = rw / 4352, rr = rw % 4352; const int L = rr < 4096 ? 4096 : 256, pos = rr < 4096 ? rr : rr - 4096;
        float pe = 0.f;
        if (C.lane == 0) pe = (float)pos / (float)(L - 1);
        else if (C.lane < 33) { const int b = (C.lane - 1) & 15; const double band = 1e-4 + (double)b * ((15.0 - 1e-4) / 15.0);
            double x = (double)pos * band / (double)L; x -= floor(x); float s, c; sincospif((float)(2.0 * x), &s, &c); pe = (C.lane < 17) ? c : -s; }
        const float* w1 = INP(I_HYW1) + l * 33 * 64; const float* w2 = INP(I_HYW2) + l * 64 * 64;
        float a = INP(I_HYB1)[l * 64 + C.lane];
#pragma unroll
        for (int i = 0; i < 33; ++i) a += __shfl(pe, i) * w1[i * 64 + C.lane];
        const float h1 = sinf(a);
        float b = INP(I_HYB2)[l * 64 + C.lane];
#pragma unroll 16
        for (int i = 0; i < 64; ++i) b += __shfl(h1, i) * w2[i * 64 + C.lane];
        H2[(size_t)l * 278528 + (rr < 4096 ? (size_t)C.lane * 4096 + pos : (size_t)262144 + C.lane * 256 + pos)] = sinf(b);
    }
}
__device__ __forceinline__ void p0_prologue(const Ctx& C) {
    mod_gemv(C);
    __syncthreads();
    convert_weights(C, 0);
    h2_rows(C);
    const int gt = C.vcu * NWAVES * 64 + C.tid, NGT = C.G * NWAVES * 64;
    float* PE = (float*)(WSP + WS_PE);
    for (int i = gt; i < 64 * 512; i += NGT) { const int p = i >> 9, j = i & 511, jj = j & 255; const float om = expf(-(float)jj * (9.210340371976184f / 256.f)); const float ang = (float)p * om; PE[i] = (j < 256) ? sinf(ang) : cosf(ang); }
    bf16* RGW = (bf16*)(WSP + WS_RGW);
    for (int i = gt; i < 2 * 2 * 2 * 4 * 4096; i += NGT) {
        const int i_ = i & 63, j = (i >> 6) & 63, hb = (i >> 12) & 3, gate = (i >> 14) & 1, d = (i >> 15) & 1, l = i >> 16;
        const float* src = INP(gate ? I_RGWX : I_RGWA) + ((((size_t)l * 2 + d) * 4 + hb) * 64 + i_) * 64 + j;
        RGW[i] = (bf16)f2bf(*src); }
}
__device__ __forceinline__ int cond_row(int m) { return m < MCTX ? 0 : 1 + ((m - MCTX) >> 12); }
template <bool INIT>
__device__ __forceinline__ void norm_rows(const Ctx& C, const float* gamma, const float* modl, int off_sh, int off_sc) {
    const int gw = C.vcu * NWAVES + C.wave, NGW = C.G * NWAVES;
    float* X = OUTP; bf16* XN = (bf16*)(WSP + WS_XN); const float* PE = (const float*)(WSP + WS_PE);
    for (int m = gw; m < M; m += NGW) {
        const int r = cond_row(m); const float* md = modl + r * 6144;
        f32x4 v[4]; float ss = 0.f;
#pragma unroll
        for (int j = 0; j < 4; ++j) { const int col = 256 * j + 4 * C.lane;
            if (INIT) { if (m < MCTX) v[j] = *(const f32x4*)(INP(I_XP) + (size_t)m * D + col);
                else { const int t = (m - MCTX) & 4095; const int p = (j < 2) ? (t >> 6) : (t & 63);
                    v[j] = *(const f32x4*)(INP(I_XS) + (size_t)(m - MCTX) * D + col) + *(const f32x4*)(PE + p * 512 + (col & 511)); }
                *(f32x4*)(X + (size_t)m * D + col) = v[j]; }
            else v[j] = *(const f32x4*)(X + (size_t)m * D + col);
            ss += (v[j].x * v[j].x + v[j].y * v[j].y) + (v[j].z * v[j].z + v[j].w * v[j].w); }
        const float rstd = __builtin_amdgcn_rsqf(wave_sum(ss) * (1.f / D) + EPS);
#pragma unroll
        for (int j = 0; j < 4; ++j) { const int col = 256 * j + 4 * C.lane;
            const f32x4 g = *(const f32x4*)(gamma + col), sc = *(const f32x4*)(md + off_sc + col), sh = *(const f32x4*)(md + off_sh + col);
            const f32x4 u = (v[j] * rstd) * g * (sc + 1.f) + sh;
            const v2u o = pk4(u.x, u.y, u.z, u.w);
            *(GAS v2u*)(XN + (size_t)m * D + col) = o; }
    }
}
__device__ __forceinline__ void final_norm(const Ctx& C) {
    const int gw = C.vcu * NWAVES + C.wave, NGW = C.G * NWAVES; float* X = OUTP; const float* gamma = INP(I_FNG);
    for (int m = gw; m < M; m += NGW) {
        f32x4 v[4]; float ss = 0.f;
#pragma unroll
        for (int j = 0; j < 4; ++j) { v[j] = *(const f32x4*)(X + (size_t)m * D + 256 * j + 4 * C.lane); ss += (v[j].x * v[j].x + v[j].y * v[j].y) + (v[j].z * v[j].z + v[j].w * v[j].w); }
        const float rstd = __builtin_amdgcn_rsqf(wave_sum(ss) * (1.f / D) + EPS);
#pragma unroll
        for (int j = 0; j < 4; ++j) { const int col = 256 * j + 4 * C.lane; *(f32x4*)(X + (size_t)m * D + col) = (v[j] * rstd) * *(const f32x4*)(gamma + col); }
    }
}
__device__ __forceinline__ void hyena_filters(const Ctx& C) {
    LAS float* w3s = (LAS float*)C.lds;
    LAS float* red = w3s + 2048;
    const float* H2 = (const float*)(WSP + WS_H2);
    for (int u = C.vcu; u < 256 + 32; u += C.G) {
        __syncthreads();
        if (u < 256) {
            const int l = u >> 7, f0 = (u & 127) * 4;
            if (C.tid < 256) { const int j = C.tid >> 2, e = C.tid & 3; w3s[j * 4 + e] = INP(I_HYW3)[((size_t)l * 64 + j) * 512 + f0 + e]; }
            __syncthreads();
            float hv[8][4];
#pragma unroll
            for (int i = 0; i < 8; ++i)
#pragma unroll
                for (int e = 0; e < 4; ++e) hv[i][e] = 0.f;
            const float* hb = H2 + (size_t)l * 278528 + C.tid;
#pragma unroll 4
            for (int j = 0; j < 64; ++j) { const f32x4 wv = *(const LAS f32x4*)(w3s + j * 4);
#pragma unroll
                for (int i = 0; i < 8; ++i) { const float h = hb[(size_t)j * 4096 + 512 * i]; hv[i][0] += h * wv.x; hv[i][1] += h * wv.y; hv[i][2] += h * wv.z; hv[i][3] += h * wv.w; } }
            float sm[4];
#pragma unroll
            for (int e = 0; e < 4; ++e) { const float dec = INP(I_HYDEC)[l * 512 + f0 + e]; float s = 0.f;
#pragma unroll
                for (int i = 0; i < 8; ++i) { const int t = C.tid + 512 * i; const float dist = fabsf((float)(t - 2048)) * (1.f / 2048.f); hv[i][e] *= expf(-dist * dec); s += fabsf(hv[i][e]); }
                sm[e] = wave_sum(s); }
            if (C.lane == 0) {
#pragma unroll
                for (int e = 0; e < 4; ++e) red[C.wave * 16 + e] = sm[e]; }
            __syncthreads();
#pragma unroll
            for (int e = 0; e < 4; ++e) { float tot = 0.f;
#pragma unroll
                for (int w8 = 0; w8 < 8; ++w8) tot += red[w8 * 16 + e];
                const float inv = 1.f / tot; float* dst = (float*)(WSP + WS_HT) + ((size_t)l * 512 + f0 + e) * 4096 + C.tid;
#pragma unroll
                for (int i = 0; i < 8; ++i) dst[512 * i] = hv[i][e] * inv; }
        } else {
            const int uu = u - 256, l = uu >> 4, f0 = (uu & 15) * 32, t = C.tid & 255, fh = C.tid >> 8;
            for (int i = C.tid; i < 2048; i += 512) { const int j = i >> 5, e = i & 31; w3s[i] = INP(I_HYW3)[((size_t)l * 64 + j) * 512 + f0 + e]; }
            __syncthreads();
            float hv[16];
#pragma unroll
            for (int e = 0; e < 16; ++e) hv[e] = 0.f;
            const float* hb = H2 + (size_t)l * 278528 + 262144 + t;
#pragma unroll 4
            for (int j = 0; j < 64; ++j) { const float h = hb[j * 256];
#pragma unroll
                for (int q = 0; q < 4; ++q) { const f32x4 wv = *(const LAS f32x4*)(w3s + j * 32 + 16 * fh + 4 * q); hv[4 * q] += h * wv.x; hv[4 * q + 1] += h * wv.y; hv[4 * q + 2] += h * wv.z; hv[4 * q + 3] += h * wv.w; } }
            const float dist = fabsf((float)(t - 128)) * (1.f / 128.f);
#pragma unroll
            for (int e = 0; e < 16; ++e) { hv[e] *= expf(-dist * INP(I_HYDEC)[l * 512 + f0 + 16 * fh + e]); const float s = wave_sum(fabsf(hv[e])); if (C.lane == 0) red[C.wave * 16 + e] = s; }
            __syncthreads();
#pragma unroll
            for (int e = 0; e < 16; ++e) { const float tot = red[(4 * fh + 0) * 16 + e] + red[(4 * fh + 1) * 16 + e] + red[(4 * fh + 2) * 16 + e] + red[(4 * fh + 3) * 16 + e];
                ((float*)(WSP + WS_HTC))[((size_t)l * 512 + f0 + 16 * fh + e) * 256 + t] = hv[e] / tot; }
        }
    }
}
__device__ __forceinline__ float gelu_tanh(float x) { const float u = 0.7978845608028654f * (x + 0.044715f * x * x * x); const float t = 1.f - 2.f * __builtin_amdgcn_rcpf(1.f + __expf(2.f * u)); return 0.5f * x * (1.f + t); }
__device__ __forceinline__ float softplusf_(float z) { return fmaxf(z, 0.f) + log1pf(__expf(-fabsf(z))); }
__device__ __forceinline__ bf16x8 pack_bf16x8(f32x4 a, f32x4 b) {
    return __builtin_bit_cast(bf16x8, pk8(a.x, a.y, a.z, a.w, b.x, b.y, b.z, b.w));
}
#ifndef PROBE_SUB
#define PROBE_SUB 0u
#endif
#define SUB_T0(k) do { if ((PROBE_SUB >> (k)) & 1u) { __syncthreads(); tsub = __builtin_amdgcn_s_memrealtime(); } } while (0)
#define SUB_T1(k) do { if ((PROBE_SUB >> (k)) & 1u) { __syncthreads(); tacc += __builtin_amdgcn_s_memrealtime() - tsub; } } while (0)
__device__ __forceinline__ void rg_main(const Ctx& C, int l, int u, unsigned long long& tacc) {
    unsigned long long tsub = 0;
    const int seg = u >> 2, hb = u & 3; const bool lat = seg >= 32; const int m0 = seg * 256;
    const int sbeg = lat ? MCTX + ((seg - 32) >> 4) * 4096 : m0, send = lat ? sbeg + 4096 : m0 + 256;
    LAS float* xc = (LAS float*)C.lds; LAS float* hs = xc + 256 * 68;
    const bf16* PROJ = (const bf16*)(WSP + WS_PROJ);
    SUB_T0(6);
    {
        const int t = C.tid >> 1, c0 = 32 * (C.tid & 1), chg = 64 * hb + c0;
        float acc[32];
        const float* cb = INP(I_RGCB) + l * 256 + chg;
#pragma unroll
        for (int e = 0; e < 32; e += 4) { const f32x4 b = *(const f32x4*)(cb + e); acc[e] = b.x; acc[e + 1] = b.y; acc[e + 2] = b.z; acc[e + 3] = b.w; }
#pragma unroll
        for (int j = 0; j < 4; ++j) { const int mr = m0 + t - 2 + j;
            if (mr >= sbeg && mr < send) { const v4u* xp = (const v4u*)(PROJ + (size_t)mr * pg8::PROJ_LD + 1024 + chg); const float* wp = INP(I_RGCW) + (l * 4 + j) * 256 + chg;
#pragma unroll
                for (int q = 0; q < 4; ++q) { const v4u xv = xp[q]; const f32x4 w0 = *(const f32x4*)(wp + 8 * q), w1 = *(const f32x4*)(wp + 8 * q + 4);
                    acc[8 * q + 0] += w0.x * bflo(xv.x); acc[8 * q + 1] += w0.y * bfhi(xv.x); acc[8 * q + 2] += w0.z * bflo(xv.y); acc[8 * q + 3] += w0.w * bfhi(xv.y);
                    acc[8 * q + 4] += w1.x * bflo(xv.z); acc[8 * q + 5] += w1.y * bfhi(xv.z); acc[8 * q + 6] += w1.z * bflo(xv.w); acc[8 * q + 7] += w1.w * bfhi(xv.w); } } }
#pragma unroll
        for (int e = 0; e < 32; e += 4) { *(LAS f32x4*)(xc + t * 68 + c0 + e) = (f32x4){acc[e], acc[e + 1], acc[e + 2], acc[e + 3]}; *(LAS f32x4*)(hs + t * 68 + c0 + e) = (f32x4){0.f, 0.f, 0.f, 0.f}; }
    }
    __syncthreads();
    SUB_T1(6);
    SUB_T0(7);
    {
        const int dir = C.wave >> 2, nt = C.wave & 3, cl = C.lane & 15, g = C.lane >> 4, ch = 16 * nt + cl, chg = 64 * hb + ch;
        const bf16* wb = (const bf16*)(WSP + WS_RGW) + ((size_t)(((l * 2 + dir) * 2 + 0) * 4 + hb) * 64 + ch) * 64 + 8 * g;
        const bf16x8 Ba0 = *(const bf16x8*)(wb), Ba1 = *(const bf16x8*)(wb + 32), Bx0 = *(const bf16x8*)(wb + 16384), Bx1 = *(const bf16x8*)(wb + 16384 + 32);
        const float ba = INP(I_RGBA)[(l * 2 + dir) * 256 + chg], bx = INP(I_RGBX)[(l * 2 + dir) * 256 + chg];
        const float c1 = -8.f * softplusf_(-INP(I_RGLAM)[(l * 2 + dir) * 256 + chg]);
        bf16* RGP = (bf16*)(WSP + WS_RGP) + (size_t)dir * 8192 * 256;
        float carry = 0.f, pc = 1.f;
#pragma unroll 1
        for (int half = 0; half < 2; ++half) {
            float a[8][4], uu[8][4], Ap[8], Up[8], At[8], Ut[8];
#pragma unroll
            for (int q = 0; q < 8; ++q) {
                const int it = 8 * half + q, t0 = 16 * (dir ? 15 - it : it);
                const LAS float* xr = xc + (t0 + cl) * 68 + 8 * g;
                const bf16x8 A0 = pack_bf16x8(*(const LAS f32x4*)(xr), *(const LAS f32x4*)(xr + 4)), A1 = pack_bf16x8(*(const LAS f32x4*)(xr + 32), *(const LAS f32x4*)(xr + 36));
                f32x4 ar = (f32x4){0.f, 0.f, 0.f, 0.f}, ax = ar;
                ar = __builtin_amdgcn_mfma_f32_16x16x32_bf16(A0, Ba0, ar, 0, 0, 0); ar = __builtin_amdgcn_mfma_f32_16x16x32_bf16(A1, Ba1, ar, 0, 0, 0);
                ax = __builtin_amdgcn_mfma_f32_16x16x32_bf16(A0, Bx0, ax, 0, 0, 0); ax = __builtin_amdgcn_mfma_f32_16x16x32_bf16(A1, Bx1, ax, 0, 0, 0);
#pragma unroll
                for (int r = 0; r < 4; ++r) { const float xv = xc[(t0 + 4 * g + r) * 68 + ch]; const float rr = sigmoidf_(ar[r] + ba), ii = sigmoidf_(ax[r] + bx);
                    const float la = c1 * rr; const float av = __expf(la); a[q][r] = av; uu[q][r] = __builtin_amdgcn_sqrtf(fmaxf(1.f - av * av, 0.f)) * ii * xv; }
                const float Aloc = (a[q][0] * a[q][1]) * (a[q][2] * a[q][3]);
                const float Uloc = dir ? ((uu[q][3] * a[q][2] + uu[q][2]) * a[q][1] + uu[q][1]) * a[q][0] + uu[q][0] : ((uu[q][0] * a[q][1] + uu[q][1]) * a[q][2] + uu[q][2]) * a[q][3] + uu[q][3];
                float ap = 1.f, up = 0.f, at = 1.f, ut = 0.f;
                if (!dir) {
#pragma unroll
                    for (int gp = 0; gp < 4; ++gp) { const float Ag = __shfl(Aloc, cl + 16 * gp), Ug = __shfl(Uloc, cl + 16 * gp); if (gp < g) { up = Ag * up + Ug; ap *= Ag; } ut = Ag * ut + Ug; at *= Ag; }
                } else {
#pragma unroll
                    for (int gp = 3; gp >= 0; --gp) { const float Ag = __shfl(Aloc, cl + 16 * gp), Ug = __shfl(Uloc, cl + 16 * gp); if (gp > g) { up = Ag * up + Ug; ap *= Ag; } ut = Ag * ut + Ug; at *= Ag; }
                }
                Ap[q] = ap; Up[q] = up; At[q] = at; Ut[q] = ut;
            }
#pragma unroll
            for (int q = 0; q < 8; ++q) {
                const int it = 8 * half + q, t0 = 16 * (dir ? 15 - it : it);
                const float hin = Ap[q] * carry + Up[q], pin = Ap[q] * pc;
                carry = At[q] * carry + Ut[q]; pc = At[q] * pc;
                float h[4], p[4];
                if (!dir) { h[0] = a[q][0] * hin + uu[q][0]; h[1] = a[q][1] * h[0] + uu[q][1]; h[2] = a[q][2] * h[1] + uu[q][2]; h[3] = a[q][3] * h[2] + uu[q][3];
                            p[0] = pin * a[q][0]; p[1] = p[0] * a[q][1]; p[2] = p[1] * a[q][2]; p[3] = p[2] * a[q][3]; }
                else      { h[3] = a[q][3] * hin + uu[q][3]; h[2] = a[q][2] * h[3] + uu[q][2]; h[1] = a[q][1] * h[2] + uu[q][1]; h[0] = a[q][0] * h[1] + uu[q][0];
                            p[3] = pin * a[q][3]; p[2] = p[3] * a[q][2]; p[1] = p[2] * a[q][1]; p[0] = p[1] * a[q][0]; }
#pragma unroll
                for (int r = 0; r < 4; ++r) { const int t = t0 + 4 * g + r;
                    (void)__hip_atomic_fetch_add(hs + t * 68 + ch, h[r], __ATOMIC_RELAXED, __HIP_MEMORY_SCOPE_WORKGROUP);
                    if (lat) RGP[(size_t)(m0 - MCTX + t) * 256 + chg] = (bf16)f2bf(p[r]); }
            }
        }
        if (g == 0) {
            if (lat) { float* ag = (float*)(WSP + WS_RGAGG) + ((size_t)((seg - 32) * 2 + dir) * 256 + chg) * 2; ag[0] = pc; ag[1] = carry; }
            else OUTP[OUT_SRG + ((size_t)(seg * 2 + l) * 2 + dir) * 256 + chg] = carry;
        }
    }
    __syncthreads();
    SUB_T1(7);
    SUB_T0(8);
    {
        const int t = C.tid >> 1, c0 = 32 * (C.tid & 1), chg = 64 * hb + c0, m = m0 + t;
        if (!lat) {
            const v4u* gp = (const v4u*)(PROJ + (size_t)m * pg8::PROJ_LD + 1280 + chg); bf16* yp = (bf16*)(WSP + WS_XN) + (size_t)m * 1024 + 256 + chg;
#pragma unroll
            for (int q = 0; q < 4; ++q) { const v4u gv = gp[q]; const f32x4 h0 = *(const LAS f32x4*)(hs + t * 68 + c0 + 8 * q), h1 = *(const LAS f32x4*)(hs + t * 68 + c0 + 8 * q + 4);
                v4u o; o.x = pk2(h0.x * gelu_tanh(bflo(gv.x)), h0.y * gelu_tanh(bfhi(gv.x))); o.y = pk2(h0.z * gelu_tanh(bflo(gv.y)), h0.w * gelu_tanh(bfhi(gv.y)));
                o.z = pk2(h1.x * gelu_tanh(bflo(gv.z)), h1.y * gelu_tanh(bfhi(gv.z))); o.w = pk2(h1.z * gelu_tanh(bflo(gv.w)), h1.w * gelu_tanh(bfhi(gv.w)));
                *(GAS v4u*)(yp + 8 * q) = o; }
        } else {
            float* hp = (float*)(WSP + WS_RGH) + (size_t)(m - MCTX) * 256 + chg;
#pragma unroll
            for (int q = 0; q < 8; ++q) *(f32x4*)(hp + 4 * q) = *(const LAS f32x4*)(hs + t * 68 + c0 + 4 * q);
        }
    }
    __syncthreads();
    SUB_T1(8);
}
__device__ __forceinline__ void rg_corr(const Ctx& C, int l, int u) {
    const int segl = u >> 2, cg = u & 3, b = segl >> 4, j = segl & 15;
    LAS float* hin = (LAS float*)C.lds;
    __syncthreads();
    if (C.tid < 128) { const int dir = C.tid >> 6, c = C.tid & 63, chg = 64 * cg + c;
        float h = INP(I_SRG)[((size_t)(b * 2 + l) * 2 + dir) * 256 + chg];
        const float* ag = (const float*)(WSP + WS_RGAGG);
        if (dir == 0) { for (int i = 0; i < j; ++i) { const float* a2 = ag + ((size_t)((b * 16 + i) * 2 + 0) * 256 + chg) * 2; h = a2[0] * h + a2[1]; } }
        else { for (int i = 15; i > j; --i) { const float* a2 = ag + ((size_t)((b * 16 + i) * 2 + 1) * 256 + chg) * 2; h = a2[0] * h + a2[1]; } }
        hin[dir * 64 + c] = h; }
    __syncthreads();
    const int t = C.tid >> 1, c0 = 32 * (C.tid & 1), chg = 64 * cg + c0, tl = segl * 256 + t, m = MCTX + tl;
    const bf16* PROJ = (const bf16*)(WSP + WS_PROJ);
    const v4u* gp = (const v4u*)(PROJ + (size_t)m * pg8::PROJ_LD + 1280 + chg); bf16* yp = (bf16*)(WSP + WS_XN) + (size_t)m * 1024 + 256 + chg;
    const float* hp = (const float*)(WSP + WS_RGH) + (size_t)tl * 256 + chg;
    const v4u* pf = (const v4u*)((const bf16*)(WSP + WS_RGP) + (size_t)tl * 256 + chg); const v4u* pb = (const v4u*)((const bf16*)(WSP + WS_RGP) + (size_t)(8192 + tl) * 256 + chg);
#pragma unroll
    for (int q = 0; q < 4; ++q) { const v4u gv = gp[q], fv = pf[q], bv = pb[q]; const f32x4 h0 = *(const f32x4*)(hp + 8 * q), h1 = *(const f32x4*)(hp + 8 * q + 4);
        const LAS float* hf = hin + c0 + 8 * q; const LAS float* hbk = hin + 64 + c0 + 8 * q;
        float hv[8];
        hv[0] = h0.x + bflo(fv.x) * hf[0] + bflo(bv.x) * hbk[0]; hv[1] = h0.y + bfhi(fv.x) * hf[1] + bfhi(bv.x) * hbk[1];
        hv[2] = h0.z + bflo(fv.y) * hf[2] + bflo(bv.y) * hbk[2]; hv[3] = h0.w + bfhi(fv.y) * hf[3] + bfhi(bv.y) * hbk[3];
        hv[4] = h1.x + bflo(fv.z) * hf[4] + bflo(bv.z) * hbk[4]; hv[5] = h1.y + bfhi(fv.z) * hf[5] + bfhi(bv.z) * hbk[5];
        hv[6] = h1.z + bflo(fv.w) * hf[6] + bflo(bv.w) * hbk[6]; hv[7] = h1.w + bfhi(fv.w) * hf[7] + bfhi(bv.w) * hbk[7];
        v4u o; o.x = pk2(hv[0] * gelu_tanh(bflo(gv.x)), hv[1] * gelu_tanh(bfhi(gv.x))); o.y = pk2(hv[2] * gelu_tanh(bflo(gv.y)), hv[3] * gelu_tanh(bfhi(gv.y)));
        o.z = pk2(hv[4] * gelu_tanh(bflo(gv.z)), hv[5] * gelu_tanh(bfhi(gv.z))); o.w = pk2(hv[6] * gelu_tanh(bflo(gv.w)), hv[7] * gelu_tanh(bfhi(gv.w)));
        *(GAS v4u*)(yp + 8 * q) = o; }
}
typedef short s16x4 __attribute__((ext_vector_type(4)));
template <int CTRL> __device__ __forceinline__ float dpp_mov_id1(float x) { return __builtin_bit_cast(float, __builtin_amdgcn_update_dpp(0x3f800000, __builtin_bit_cast(int, x), CTRL, 0xf, 0xf, false)); }
__device__ __forceinline__ float row_cumprod16(float x) { x *= dpp_mov_id1<0x111>(x); x *= dpp_mov_id1<0x112>(x); x *= dpp_mov_id1<0x114>(x); x *= dpp_mov_id1<0x118>(x); return x; }
__device__ __forceinline__ s16x4 pack_bf16x4(float a, float b, float c, float d) { return __builtin_bit_cast(s16x4, pk4(a, b, c, d)); }
__device__ __forceinline__ bf16x8 pack_bf16x8s(float a0, float a1, float a2, float a3, float a4, float a5, float a6, float a7) {
    return __builtin_bit_cast(bf16x8, pk8(a0, a1, a2, a3, a4, a5, a6, a7)); }

#define GLA_LOAD_RAW(R, cidx) do { const int ts_ = dir ? 255 - (16 * (cidx) + tt) : 16 * (cidx) + tt; const bf16* row_ = PROJ + (size_t)(m0 + ts_) * pg8::PROJ_LD; \
        _Pragma("unroll") for (int i_ = 0; i_ < 4; ++i_) { R.k[i_] = *(const v2u*)(row_ + kcol + hc + 16 * i_ + 4 * g); } \
        R.v0 = *(const v4u*)(row_ + vcol + hc + 16 * g); R.v1 = *(const v4u*)(row_ + vcol + hc + 16 * g + 8); if (mixer == 0) R.lr = *(const v2u*)(row_ + 2816 + 4 * g); } while (0)
struct GlaRaw { v2u k[4]; v4u v0, v1; v2u lr; };
template <bool MAIN, int mixer>
__device__ __forceinline__ void gla3_unit(const Ctx& C, int l, int seg, int head_arg) {
    if (MAIN && C.wave >= 4) { __syncthreads(); __syncthreads(); return; }
    const int head = MAIN ? 2 * head_arg + ((C.wave >> 1) & 1) : head_arg, dir = MAIN ? (C.wave & 1) : (C.wave >> 2), quarter = C.wave & 3;
    const int lane = C.lane, tt = lane & 15, g = lane >> 4;
    LAS bf16* Vt = (LAS bf16*)(C.lds + C.wave * 5376); LAS bf16* Kt = Vt + 16 * 80; LAS float* ctab = (LAS float*)(Kt + 16 * 80);
    const bool lat = seg >= 32; const int m0 = seg * 256, hc = 64 * head;
    const bf16* PROJ = (const bf16*)(WSP + WS_PROJ);
    s16x4 WgA[4];
#pragma unroll
    for (int i = 0; i < 4; ++i) WgA[i] = (s16x4){0, 0, 0, 0};
    if (mixer == 0) {
        const float* wg = INP(I_GLAWG) + (size_t)(l * 2 + dir) * 16 * 256 + hc;
#pragma unroll
        for (int i = 0; i < 4; ++i) WgA[i] = pack_bf16x4(wg[(4 * g + 0) * 256 + 16 * i + tt], wg[(4 * g + 1) * 256 + 16 * i + tt], wg[(4 * g + 2) * 256 + 16 * i + tt], wg[(4 * g + 3) * 256 + 16 * i + tt]);
        ctab[lane] = INP(I_GLABG)[(l * 2 + dir) * 256 + hc + lane];
    } else ctab[lane] = (l > 0) ? sigmoidf_(INP(I_HGLOW)[256 + hc + lane] - INP(I_HGLOW)[hc + lane]) : 0.f;
    f32x4 S[4][4];
    const unsigned soff0 = (unsigned)((4 * g) * 64 + tt);
#pragma unroll
    for (int kt = 0; kt < 4; ++kt)
#pragma unroll
        for (int vt = 0; vt < 4; ++vt) S[kt][vt] = (f32x4){0.f, 0.f, 0.f, 0.f};
    if (MAIN && lat) {
        const int segl = seg - 32, b = segl >> 4, jseg = segl & 15;
        const float* st = INP(mixer ? I_SHG : I_SGLA) + ((size_t)(((b * 2 + l) * 2 + dir) * 4 + head) * 64) * 64;
#pragma unroll
        for (int kt = 0; kt < 4; ++kt)
#pragma unroll
            for (int r = 0; r < 4; ++r) { unsigned o = soff0 + (unsigned)((16 * kt + r) * 64); asm volatile("" : "+v"(o) :: "memory");
#pragma unroll
                for (int vt = 0; vt < 4; ++vt) S[kt][vt][r] = st[o + 16 * vt]; }
        const float* GS = (const float*)(WSP + WS_GS); const float* GD = (const float*)(WSP + WS_GD);
        const int i0 = dir ? 15 : 0, di = dir ? -1 : 1;
#pragma unroll 1
        for (int i = i0; i != jseg; i += di) { const size_t ub = (size_t)((((b * 16 + i) * 2 + mixer) * 4 + head) * 2 + dir) * 64;
            const float* GSu = GS + ub * 64;
#pragma unroll
            for (int kt = 0; kt < 4; ++kt) { const f32x4 dv = *(const f32x4*)(GD + ub + 16 * kt + 4 * g);
#pragma unroll
                for (int r = 0; r < 4; ++r) { unsigned o = soff0 + (unsigned)((16 * kt + r) * 64); asm volatile("" : "+v"(o) :: "memory");
#pragma unroll
                    for (int vt = 0; vt < 4; ++vt) S[kt][vt][r] = dv[r] * S[kt][vt][r] + GSu[o + 16 * vt]; } } }
    }
    float dtot[4][4];
#pragma unroll
    for (int i = 0; i < 4; ++i)
#pragma unroll
        for (int e = 0; e < 4; ++e) dtot[i][e] = 1.f;
    const int qcol = mixer ? 1536 : 0, kcol = mixer ? (dir ? 2048 : 1792) : 256, vcol = mixer ? 2304 : 512, gcol = mixer ? 2560 : 768, ycol = mixer ? 768 : 0;
    float* OS = (float*)(WSP + WS_OSUM) + 256 * mixer + hc;
    bf16* Yb = (bf16*)(WSP + WS_XN) + ycol + hc;
    f32x4 gnv = (f32x4){0.f, 0.f, 0.f, 0.f};
    if (MAIN) { const float* gn = INP(mixer ? I_HGNG : I_GLANG) + l * 256 + hc + tt; gnv = (f32x4){gn[0], gn[16], gn[32], gn[48]}; }
    const int trq = tt >> 2, trp = tt & 3;
    constexpr int NCH = MAIN ? 16 : 4; const int cbase = MAIN ? 0 : 4 * quarter;
    GlaRaw cur; GLA_LOAD_RAW(cur, cbase);
#pragma unroll 1
    for (int ci = 0; ci < NCH; ++ci) {
        const int c = cbase + ci;
        GlaRaw nxt; { const int cn = cbase + (ci + 1 < NCH ? ci + 1 : ci); GLA_LOAD_RAW(nxt, cn); }
        if (MAIN && ci == 8) { VM_WAIT(); __syncthreads(); }
        *(LAS v4u*)(Vt + tt * 80 + 16 * g) = cur.v0; *(LAS v4u*)(Vt + tt * 80 + 16 * g + 8) = cur.v1;
        v2u qraw[4];
        if (MAIN) { const int ts_ = dir ? 255 - (16 * c + tt) : 16 * c + tt; const bf16* row_ = PROJ + (size_t)(m0 + ts_) * pg8::PROJ_LD;
#pragma unroll
            for (int i = 0; i < 4; ++i) qraw[i] = *(const v2u*)(row_ + qcol + hc + 16 * i + 4 * g); }
        float a[4][4], kk[4][4], qq[4][4];
        if (mixer == 0) {
            const s16x4 lrb = __builtin_bit_cast(s16x4, cur.lr);
#pragma unroll
            for (int i = 0; i < 4; ++i) { const f32x4 x = __builtin_amdgcn_mfma_f32_16x16x16bf16_1k(WgA[i], lrb, *(const LAS f32x4*)(ctab + 16 * i + 4 * g), 0, 0, 0);
#pragma unroll
                for (int e = 0; e < 4; ++e) { const float xe = fmaxf(x[e], -60.f); a[i][e] = __builtin_amdgcn_exp2f(-0.0625f * __builtin_amdgcn_logf(1.f + __expf(-xe))); }
                kk[i][0] = bflo(cur.k[i].x); kk[i][1] = bfhi(cur.k[i].x); kk[i][2] = bflo(cur.k[i].y); kk[i][3] = bfhi(cur.k[i].y);
                if (MAIN) { qq[i][0] = 0.125f * bflo(qraw[i].x); qq[i][1] = 0.125f * bfhi(qraw[i].x); qq[i][2] = 0.125f * bflo(qraw[i].y); qq[i][3] = 0.125f * bfhi(qraw[i].y); } }
        } else {
#pragma unroll
            for (int i = 0; i < 4; ++i) { float fl[4] = {bflo(cur.k[i].x), bfhi(cur.k[i].x), bflo(cur.k[i].y), bfhi(cur.k[i].y)}; const f32x4 lbq = *(const LAS f32x4*)(ctab + 16 * i + 4 * g);
#pragma unroll
                for (int e = 0; e < 4; ++e) { const float ef = __expf(-fmaxf(fl[e], -80.f)); const float sg = __builtin_amdgcn_rcpf(1.f + ef); const float sn = ef * sg;
                    a[i][e] = lbq[e] + (1.f - lbq[e]) * sg; kk[i][e] = (1.f - lbq[e]) * sn; }
                if (MAIN) { float dq[4] = {bflo(qraw[i].x), bfhi(qraw[i].x), bflo(qraw[i].y), bfhi(qraw[i].y)};
#pragma unroll
                    for (int e = 0; e < 4; ++e) qq[i][e] = dq[e] * __builtin_amdgcn_rcpf(1.f + __expf(-dq[e])); } }
        }
        float Aend[4][4]; bf16x8 qf[2], kf[2];
#pragma unroll
        for (int i = 0; i < 4; ++i) { float qh[4], kh_[4], kt_[4];
#pragma unroll
            for (int e = 0; e < 4; ++e) { const float A = row_cumprod16(a[i][e]); Aend[i][e] = __shfl(A, (lane & 48) | 15); const float rA = __builtin_amdgcn_rcpf(A);
                kh_[e] = kk[i][e] * rA; kt_[e] = kh_[e] * Aend[i][e]; if (MAIN) qh[e] = qq[i][e] * A; if (!MAIN) dtot[i][e] *= Aend[i][e]; }
            *(LAS s16x4*)(Kt + tt * 80 + 16 * i + 4 * g) = pack_bf16x4(kt_[0], kt_[1], kt_[2], kt_[3]);
            if (MAIN) { const v2u qw = __builtin_bit_cast(v2u, pack_bf16x4(qh[0], qh[1], qh[2], qh[3])), kw = __builtin_bit_cast(v2u, pack_bf16x4(kh_[0], kh_[1], kh_[2], kh_[3]));
                v4u tq = __builtin_bit_cast(v4u, qf[i >> 1]), tk = __builtin_bit_cast(v4u, kf[i >> 1]);
                if (i & 1) { tq.z = qw.x; tq.w = qw.y; tk.z = kw.x; tk.w = kw.y; } else { tq.x = qw.x; tq.y = qw.y; tk.x = kw.x; tk.y = kw.y; }
                qf[i >> 1] = __builtin_bit_cast(bf16x8, tq); kf[i >> 1] = __builtin_bit_cast(bf16x8, tk); } }
        float po[4][4]; unsigned short gz[4][4];
        if (MAIN && ci >= 8) {
#pragma unroll
            for (int r = 0; r < 4; ++r) { const int tr = 4 * g + r; const int tsr = dir ? 255 - (16 * c + tr) : 16 * c + tr; const unsigned mo = (unsigned)(m0 + tsr);
#pragma unroll
                for (int vt = 0; vt < 4; ++vt) { po[vt][r] = OS[mo * 512u + (unsigned)tt + 16u * vt]; gz[vt][r] = PROJ[mo * (unsigned)pg8::PROJ_LD + (unsigned)(gcol + hc + 16 * vt + tt)]; } }
        }
        s16x4 Vb[4], Kb[4];
#pragma unroll
        for (int t4 = 0; t4 < 4; ++t4) { Vb[t4] = __builtin_amdgcn_ds_read_tr16_b64_v4i16((LAS s16x4*)(Vt + (4 * g + trq) * 80 + 16 * t4 + 4 * trp));
                                           Kb[t4] = __builtin_amdgcn_ds_read_tr16_b64_v4i16((LAS s16x4*)(Kt + (4 * g + trq) * 80 + 16 * t4 + 4 * trp)); }
        if (MAIN) {
            f32x4 pa = (f32x4){0.f, 0.f, 0.f, 0.f};
            pa = __builtin_amdgcn_mfma_f32_16x16x32_bf16(kf[0], qf[0], pa, 0, 0, 0); pa = __builtin_amdgcn_mfma_f32_16x16x32_bf16(kf[1], qf[1], pa, 0, 0, 0);
            const s16x4 Pa = pack_bf16x4(4 * g + 0 <= tt ? pa[0] : 0.f, 4 * g + 1 <= tt ? pa[1] : 0.f, 4 * g + 2 <= tt ? pa[2] : 0.f, 4 * g + 3 <= tt ? pa[3] : 0.f);
            f32x4 ov[4];
#pragma unroll
            for (int vt = 0; vt < 4; ++vt) { f32x4 o = (f32x4){0.f, 0.f, 0.f, 0.f};
                const bf16x8 sb0 = pack_bf16x8s(S[0][vt][0], S[0][vt][1], S[0][vt][2], S[0][vt][3], S[1][vt][0], S[1][vt][1], S[1][vt][2], S[1][vt][3]);
                const bf16x8 sb1 = pack_bf16x8s(S[2][vt][0], S[2][vt][1], S[2][vt][2], S[2][vt][3], S[3][vt][0], S[3][vt][1], S[3][vt][2], S[3][vt][3]);
                    o = __builtin_amdgcn_mfma_f32_16x16x16bf16_1k(Pa, Vb[vt], o, 0, 0, 0);
                o = __builtin_amdgcn_mfma_f32_16x16x32_bf16(qf[0], sb0, o, 0, 0, 0); ov[vt] = __builtin_amdgcn_mfma_f32_16x16x32_bf16(qf[1], sb1, o, 0, 0, 0); }
            if (ci < 8) {
#pragma unroll
                for (int r = 0; r < 4; ++r) { const int tr = 4 * g + r; const int tsr = dir ? 255 - (16 * c + tr) : 16 * c + tr; const unsigned mo = (unsigned)(m0 + tsr);
#pragma unroll
                    for (int vt = 0; vt < 4; ++vt) OS[mo * 512u + (unsigned)tt + 16u * vt] = ov[vt][r]; }
            } else {
#pragma unroll
                for (int r = 0; r < 4; ++r) { float ss = 0.f;
#pragma unroll
                    for (int vt = 0; vt < 4; ++vt) { ov[vt][r] += po[vt][r]; ss += ov[vt][r] * ov[vt][r]; }
                    ss += __shfl_xor(ss, 1); ss += __shfl_xor(ss, 2); ss += __shfl_xor(ss, 4); ss += __shfl_xor(ss, 8);
                    const float rstd = __builtin_amdgcn_rsqf(ss * (1.f / 64.f) + EPS);
                    const int tr = 4 * g + r; const int tsr = dir ? 255 - (16 * c + tr) : 16 * c + tr; const unsigned mo = (unsigned)(m0 + tsr);
#pragma unroll
                    for (int vt = 0; vt < 4; ++vt) { const float z = bf2f(gz[vt][r]); Yb[mo * 1024u + (unsigned)tt + 16u * vt] = (bf16)f2bf(ov[vt][r] * rstd * gnv[vt] * z * sigmoidf_(z)); } }
            }
        }
#pragma unroll
        for (int kt = 0; kt < 4; ++kt)
#pragma unroll
            for (int vt = 0; vt < 4; ++vt) { f32x4 s = S[kt][vt]; s[0] *= Aend[kt][0]; s[1] *= Aend[kt][1]; s[2] *= Aend[kt][2]; s[3] *= Aend[kt][3];
                S[kt][vt] = __builtin_amdgcn_mfma_f32_16x16x16bf16_1k(Kb[kt], Vb[vt], s, 0, 0, 0); }
        cur = nxt;
    }
    if (MAIN) {
        if (!lat) { float* so = OUTP + (mixer ? OUT_SHG : OUT_SGLA) + ((size_t)(((seg * 2 + l) * 2 + dir) * 4 + head) * 64) * 64;
#pragma unroll
            for (int kt = 0; kt < 4; ++kt)
#pragma unroll
                for (int r = 0; r < 4; ++r) { unsigned o = soff0 + (unsigned)((16 * kt + r) * 64); asm volatile("" : "+v"(o) :: "memory");
#pragma unroll
                    for (int vt = 0; vt < 4; ++vt) so[o + 16 * vt] = S[kt][vt][r]; } }
    } else {
        __syncthreads();
        LAS float* SP = (LAS float*)C.lds + C.wave * 4096; LAS float* DP = (LAS float*)C.lds + 8 * 4096 + C.wave * 64;
#pragma unroll
        for (int kt = 0; kt < 4; ++kt)
#pragma unroll
            for (int r = 0; r < 4; ++r)
#pragma unroll
                for (int vt = 0; vt < 4; ++vt) SP[soff0 + (16 * kt + r) * 64 + 16 * vt] = S[kt][vt][r];
        if (tt == 0) {
#pragma unroll
            for (int i = 0; i < 4; ++i) *(LAS f32x4*)(DP + 16 * i + 4 * g) = (f32x4){dtot[i][0], dtot[i][1], dtot[i][2], dtot[i][3]}; }
        __syncthreads();
        const int segl = seg - 32;
        const LAS float* SA = (const LAS float*)C.lds; const LAS float* DA = SA + 8 * 4096;
#pragma unroll 1
        for (int it = 0; it < 16; ++it) { const int e = C.tid + 512 * it, d = e >> 12, kv = e & 4095, k = kv >> 6;
            float sv = SA[(4 * d + 0) * 4096 + kv];
#pragma unroll
            for (int q = 1; q < 4; ++q) sv = sv * DA[(4 * d + q) * 64 + k] + SA[(4 * d + q) * 4096 + kv];
            ((float*)(WSP + WS_GS))[((size_t)(((segl * 2 + mixer) * 4 + head) * 2 + d) * 64) * 64 + kv] = sv; }
        if (C.tid < 128) { const int d = C.tid >> 6, k = C.tid & 63;
            ((float*)(WSP + WS_GD))[(size_t)(((segl * 2 + mixer) * 4 + head) * 2 + d) * 64 + k] = (DA[(4 * d) * 64 + k] * DA[(4 * d + 1) * 64 + k]) * (DA[(4 * d + 2) * 64 + k] * DA[(4 * d + 3) * 64 + k]); }
    }
    __syncthreads();
}
__device__ __forceinline__ int PIX(int i) { return i + (i >> 3); }
__device__ __forceinline__ f32x2 cmul(f32x2 a, f32x2 b) { return (f32x2){a.x * b.x - a.y * b.y, a.x * b.y + a.y * b.x}; }
__device__ __forceinline__ f32x2 cmulc(f32x2 a, f32x2 b) { return (f32x2){a.x * b.x + a.y * b.y, a.y * b.x - a.x * b.y}; }
template <bool INV> __device__ __forceinline__ f32x2 crot(f32x2 a) { return INV ? (f32x2){-a.y, a.x} : (f32x2){a.y, -a.x}; }
template <bool INV> __device__ __forceinline__ void dft8(f32x2 (&x)[8]) {
    const float h = 0.70710678118654752f;
    const f32x2 a0 = x[0] + x[4], a1 = x[0] - x[4], a2 = x[2] + x[6], a3 = crot<INV>(x[2] - x[6]);
    const f32x2 e0 = a0 + a2, e2 = a0 - a2, e1 = a1 + a3, e3 = a1 - a3;
    const f32x2 c0 = x[1] + x[5], c1 = x[1] - x[5], c2 = x[3] + x[7], c3 = crot<INV>(x[3] - x[7]);
    const f32x2 o0 = c0 + c2, o2r = c0 - c2, o1r = c1 + c3, o3r = c1 - c3;
    const f32x2 o1 = INV ? (f32x2){(o1r.x - o1r.y) * h, (o1r.y + o1r.x) * h} : (f32x2){(o1r.x + o1r.y) * h, (o1r.y - o1r.x) * h};
    const f32x2 o3 = INV ? (f32x2){-(o3r.x + o3r.y) * h, (o3r.x - o3r.y) * h} : (f32x2){(o3r.y - o3r.x) * h, -(o3r.x + o3r.y) * h};
    const f32x2 o2 = crot<INV>(o2r);
    x[0] = e0 + o0; x[1] = e1 + o1; x[2] = e2 + o2; x[3] = e3 + o3; x[4] = e0 - o0; x[5] = e1 - o1; x[6] = e2 - o2; x[7] = e3 - o3;
}
template <bool INV> __device__ __forceinline__ void dft16(f32x2 (&x)[16]) {
    f32x2 E[8], O[8];
#pragma unroll
    for (int k = 0; k < 8; ++k) { E[k] = x[2 * k]; O[k] = x[2 * k + 1]; }
    dft8<INV>(E); dft8<INV>(O);
    const float cs[8] = {1.f, 0.92387953251128674f, 0.70710678118654752f, 0.38268343236508977f, 0.f, -0.38268343236508977f, -0.70710678118654752f, -0.92387953251128674f};
    const float sn[8] = {0.f, 0.38268343236508977f, 0.70710678118654752f, 0.92387953251128674f, 1.f, 0.92387953251128674f, 0.70710678118654752f, 0.38268343236508977f};
#pragma unroll
    for (int k = 0; k < 8; ++k) { const f32x2 w = (f32x2){cs[k], INV ? sn[k] : -sn[k]}; const f32x2 o = cmul(O[k], w); x[k] = E[k] + o; x[k + 8] = E[k] - o; }
}
template <bool INV, int NC> __device__ __forceinline__ void fft_pass8(LAS f32x2* X, int tid) {
    constexpr int Q = NC / 8, ST = (NC == 512) ? 72 : (NC == 64) ? 9 : 1;
#pragma unroll 1
    for (int rep = 0; rep < 2; ++rep) { const int b = tid + 512 * rep, blk = b / Q, pos = b % Q, base = blk * NC + pos;
        LAS f32x2* Xb = X + PIX(base);
        f32x2 v[8];
#pragma unroll
        for (int q = 0; q < 8; ++q) v[q] = Xb[q * ST];
        f32x2 w1 = (f32x2){1.f, 0.f};
        if (NC > 8) { float s, c; sincospif((float)pos * (2.f / NC), &s, &c); w1 = (f32x2){c, -s}; }
        if (!INV) { dft8<false>(v);
            if (NC > 8) { f32x2 w = w1;
#pragma unroll
                for (int r = 1; r < 8; ++r) { v[r] = cmul(v[r], w); w = cmul(w, w1); } } }
        else { if (NC > 8) { f32x2 w = w1;
#pragma unroll
                for (int r = 1; r < 8; ++r) { v[r] = cmulc(v[r], w); w = cmul(w, w1); } }
            dft8<true>(v); }
#pragma unroll
        for (int q = 0; q < 8; ++q) Xb[q * ST] = v[q]; }
    __syncthreads();
}
template <bool INV> __device__ __forceinline__ void fft_pass16(LAS f32x2* X, int tid) {
    f32x2 v[16]; LAS f32x2* Xb = X + PIX(tid);
#pragma unroll
    for (int q = 0; q < 16; ++q) v[q] = Xb[576 * q];
    float s, c; sincospif((float)tid * (1.f / 4096.f), &s, &c); const f32x2 w1 = (f32x2){c, -s};
    if (!INV) { dft16<false>(v); f32x2 w = w1;
#pragma unroll
        for (int r = 1; r < 16; ++r) { v[r] = cmul(v[r], w); w = cmul(w, w1); } }
    else { f32x2 w = w1;
#pragma unroll
        for (int r = 1; r < 16; ++r) { v[r] = cmulc(v[r], w); w = cmul(w, w1); }
        dft16<true>(v); }
#pragma unroll
    for (int q = 0; q < 16; ++q) Xb[576 * q] = v[q];
    __syncthreads();
}
__device__ __forceinline__ void fft_fwd(LAS f32x2* x, int tid, bool lat) { if (lat) fft_pass16<false>(x, tid); fft_pass8<false, 512>(x, tid); fft_pass8<false, 64>(x, tid); fft_pass8<false, 8>(x, tid); }
__device__ __forceinline__ void fft_inv(LAS f32x2* x, int tid, bool lat) { fft_pass8<true, 8>(x, tid); fft_pass8<true, 64>(x, tid); fft_pass8<true, 512>(x, tid); if (lat) fft_pass16<true>(x, tid); }
template <int ORDER>
__device__ __forceinline__ void hy_unit(const Ctx& C, int l, int stream, int c) {
    LAS f32x2* x = (LAS f32x2*)C.lds; LAS v2u* ZG = (LAS v2u*)(x + 9216);
    const int f = ORDER * 256 + c; const bool lat = stream != 0;
    const int slen = stream ? 4096 : 256;
    const int zc = c, gc = (ORDER + 1) * 256 + c;
    __syncthreads();
    {   int tid = C.tid; asm volatile("" : "+v"(tid));
        LAS f32x2* xt = x + PIX(tid);
        if (stream) { const float* h = (const float*)(WSP + WS_HT) + ((size_t)l * 512 + f) * 4096;
#pragma unroll
            for (int i = 0; i < 8; ++i) { xt[576 * i] = (f32x2){h[(unsigned)(tid + 512 * i)], 0.f}; xt[576 * (i + 8)] = (f32x2){0.f, 0.f}; } }
        else { const float* h = (const float*)(WSP + WS_HTC) + ((size_t)l * 512 + f) * 256; const float hv = tid < 256 ? h[(unsigned)tid] : 0.f;
#pragma unroll
            for (int i = 0; i < 16; ++i) xt[576 * i] = (f32x2){hv, 0.f}; }
    }
    __syncthreads();
    fft_fwd(x, C.tid, lat);
    f32x2 H[16];
    {   LAS f32x2* xt = x + PIX(C.tid);
#pragma unroll
        for (int i = 0; i < 16; ++i) H[i] = xt[576 * i]; }
    __syncthreads();
    {   int tid = C.tid; asm volatile("" : "+v"(tid));
        LAS f32x2* xt = x + PIX(tid);
        const float* cw = INP(I_HYCW) + (size_t)l * 3 * 768; const float* cbp = INP(I_HYCB) + (size_t)l * 768;
        const float zw0 = cw[zc], zw1 = cw[768 + zc], zw2 = cw[1536 + zc], zb = cbp[zc];
        const float gw0 = cw[gc], gw1 = cw[768 + gc], gw2 = cw[1536 + gc], gb = cbp[gc];
        const bf16* CTv = (const bf16*)(WSP + WS_CT) + ((size_t)(c * 2 + stream) * 2) * 8192;
        const float* Z1 = (const float*)(WSP + WS_CT) + (size_t)c * 16384;
        const bool tval = stream ? true : (tid < 256);
#pragma unroll
        for (int i = 0; i < 16; ++i) {
            const bool valid = stream ? (i < 8) : tval;
            float zr = 0.f, zi = 0.f;
            if (valid) {
                const int pos = stream ? tid + 512 * i : tid;
                const unsigned mre = stream ? MCTX + pos : (2 * i) * 256 + pos, mim = mre + slen;
                const bool hasl = pos > 0, hasr = pos + 1 < slen;
                if (ORDER == 0) {
                    const bf16* v0 = CTv + (mre & 8191u); const bf16* v1 = CTv + (mim & 8191u);
                    zr = zb + zw1 * bf2f(v0[0]) + (hasl ? zw0 * bf2f(v0[-1]) : 0.f) + (hasr ? zw2 * bf2f(v0[1]) : 0.f);
                    zi = zb + zw1 * bf2f(v1[0]) + (hasl ? zw0 * bf2f(v1[-1]) : 0.f) + (hasr ? zw2 * bf2f(v1[1]) : 0.f);
                    const bf16* g0 = v0 + 8192; const bf16* g1 = v1 + 8192;
                    const float gr = gb + gw1 * bf2f(g0[0]) + (hasl ? gw0 * bf2f(g0[-1]) : 0.f) + (hasr ? gw2 * bf2f(g0[1]) : 0.f);
                    const float gi = gb + gw1 * bf2f(g1[0]) + (hasl ? gw0 * bf2f(g1[-1]) : 0.f) + (hasr ? gw2 * bf2f(g1[1]) : 0.f);
                    ZG[tid + 512 * i] = pk4(zr, zi, gr, gi);
                } else { zr = Z1[mre]; zi = Z1[mim]; }
            }
            xt[576 * i] = (f32x2){zr, zi};
        }
    }
    __syncthreads();
    fft_fwd(x, C.tid, lat);
    {   LAS f32x2* xt = x + PIX(C.tid);
#pragma unroll
        for (int i = 0; i < 16; ++i) { const f32x2 a = xt[576 * i]; xt[576 * i] = cmul(a, H[i]); } }
    __syncthreads();
    fft_inv(x, C.tid, lat);
    {   int tid2 = C.tid; asm volatile("" : "+v"(tid2));
        const float skip = INP(I_HYSKIP)[l * 512 + f];
        const float scale = stream ? (1.f / 8192.f) : (1.f / 512.f);
        const bool tval2 = stream ? true : (tid2 < 256);
        bf16* Yb = (bf16*)(WSP + WS_XN) + 512 + c; float* Z1 = (float*)(WSP + WS_CT) + (size_t)c * 16384;
        const bf16* CT2 = (const bf16*)(WSP + WS_CT2) + (size_t)c * 16384;
        const float* cw = INP(I_HYCW) + (size_t)l * 3 * 768; const float gw0 = cw[gc], gw1 = cw[768 + gc], gw2 = cw[1536 + gc], gb = INP(I_HYCB)[(size_t)l * 768 + gc];
        const LAS f32x2* xo = x + PIX(tid2) + (stream ? 2304 : 144);
#pragma unroll
        for (int i = 0; i < 16; ++i) {
            const bool valid = stream ? (i < 8) : tval2;
            if (valid) {
                const int pos = stream ? tid2 + 512 * i : tid2;
                const unsigned mre = stream ? MCTX + pos : (2 * i) * 256 + pos, mim = mre + slen;
                const f32x2 y = xo[576 * i];
                float zr, zi, gr, gi;
                if (ORDER == 0) { const v2u zz = ZG[tid2 + 512 * i]; zr = bflo(zz.x); zi = bfhi(zz.x); gr = bflo(zz.y); gi = bfhi(zz.y); }
                else { zr = Z1[mre]; zi = Z1[mim]; const bool hasl = pos > 0, hasr = pos + 1 < slen; const bf16* g0 = CT2 + mre; const bf16* g1 = CT2 + mim;
                    gr = gb + gw1 * bf2f(g0[0]) + (hasl ? gw0 * bf2f(g0[-1]) : 0.f) + (hasr ? gw2 * bf2f(g0[1]) : 0.f);
                    gi = gb + gw1 * bf2f(g1[0]) + (hasl ? gw0 * bf2f(g1[-1]) : 0.f) + (hasr ? gw2 * bf2f(g1[1]) : 0.f); }
                const float ore = gr * (y.x * scale + skip * zr), oim = gi * (y.y * scale + skip * zi);
                if (ORDER == 0) { Z1[mre] = ore; Z1[mim] = oim; }
                else { Yb[mre * 1024u] = (bf16)f2bf(ore); Yb[mim * 1024u] = (bf16)f2bf(oim); }
            }
        }
    }
    __syncthreads();
}
#ifndef PROBE_BLK
#define PROBE_BLK 0
#endif
__device__ __forceinline__ void mixers_pass1(const Ctx& C, int l, unsigned long long& tacc) {
    unsigned long long tsub = 0;
    SUB_T0(0);
    for (int rep = 0; rep < REP_RG; ++rep)
    for (int u = C.vcu; u < 256; u += C.G) rg_main(C, l, u, tacc);
    SUB_T1(0);
    __syncthreads();
    SUB_T0(1);
    for (int u = C.vcu; u < 256; u += C.G) { hy_unit<0>(C, l, 1, u); hy_unit<0>(C, l, 0, u); }
    SUB_T1(1);
    SUB_T0(2);
    for (int u = C.vcu; u < 256; u += C.G) { if (u & 4) gla3_unit<false, 1>(C, l, 32 + (u >> 3), u & 3); else gla3_unit<false, 0>(C, l, 32 + (u >> 3), u & 3); }
    SUB_T1(2);
}
__device__ __forceinline__ void mixers_pass2(const Ctx& C, int l, unsigned long long& tacc) {
    unsigned long long tsub = 0;
    SUB_T0(3);
    for (int u = C.vcu; u < 256; u += C.G) { if (u & 2) gla3_unit<true, 1>(C, l, u >> 2, u & 1); else gla3_unit<true, 0>(C, l, u >> 2, u & 1); }
    SUB_T1(3);
    __syncthreads();
    SUB_T0(4);
    for (int rep = 0; rep < REP_HY; ++rep)
    for (int u = C.vcu; u < 256; u += C.G) { hy_unit<1>(C, l, 1, u); hy_unit<1>(C, l, 0, u); }
    SUB_T1(4);
    SUB_T0(5);
    for (int u = C.vcu; u < 128; u += C.G) rg_corr(C, l, u);
    SUB_T1(5);
}
#ifndef PROBE_MASK
#define PROBE_MASK 0u
#endif
#define PH_T0(k) do { if ((PROBE_MASK >> (k)) & 1u) tph = __builtin_amdgcn_s_memrealtime(); } while (0)
#define PH_T1(k) do { if ((PROBE_MASK >> (k)) & 1u) tacc += __builtin_amdgcn_s_memrealtime() - tph; } while (0)
template <int l>
__device__ __forceinline__ void layer_phases(LAS unsigned char* ldsb, const int lo, const int hi, const XcdBarrier& bar, unsigned long long& tacc) {
    unsigned long long tph = 0;
#define IN(k) (lo <= (k) && (k) < hi)
#define SEAM(k) do { if (IN((k) + 1)) xcd_barrier(bar); } while (0)
    float* const modp = (float*)(WSP + WS_MOD);
    bf16* const XN = (bf16*)(WSP + WS_XN); bf16* const PROJ = (bf16*)(WSP + WS_PROJ);
        constexpr int pb = (l == 0) ? 2 : 10;
        const float* modl = modp + (size_t)l * 3 * 6144;
        if (IN(pb + 0)) {
            PH_T0(pb + 0);
            const Ctx C = make_ctx(ldsb);
            pg8::Gemm g{XN, (const bf16*)(WSP + WS_WIN), M, NIN, D}; pg8::StaticOrder S; S.init(M, NIN, C.G, (int)blockIdx.x);
            pg8::EpiProj E{PROJ, (bf16*)(WSP + WS_CT), (bf16*)(WSP + WS_CT2)};
            for (int rep = 0; rep < REP_GIN; ++rep)
            pg8::gemm_phase<pg8::EpiProj, pg8::StaticOrder, true, true>(C.lds, g, S, E);
            SEAM(pb + 0); PH_T1(pb + 0);
        }
        if (IN(pb + 1)) { PH_T0(pb + 1); const Ctx C = make_ctx(ldsb); mixers_pass1(C, l, tacc); SEAM(pb + 1); PH_T1(pb + 1); }
        if (IN(pb + 2)) { PH_T0(pb + 2); const Ctx C = make_ctx(ldsb); mixers_pass2(C, l, tacc); SEAM(pb + 2); PH_T1(pb + 2); }
        if (IN(pb + 3)) {
            PH_T0(pb + 3);
            const Ctx C = make_ctx(ldsb);
            pg8::Gemm g{XN, (const bf16*)(WSP + WS_WOUT), M, D, D}; pg8::StaticOrder S; S.init(M, D, C.G, (int)blockIdx.x);
            pg8::EpiResid E{OUTP, modl + 2048};
            pg8::gemm_phase<pg8::EpiResid, pg8::StaticOrder, true, true>(C.lds, g, S, E);
            SEAM(pb + 3); PH_T1(pb + 3);
        }
        if (IN(pb + 4)) { PH_T0(pb + 4); const Ctx C = make_ctx(ldsb); for (int rep = 0; rep < REP_NORM; ++rep) norm_rows<false>(C, INP(I_N2G) + l * D, modl, 3072, 4096); SEAM(pb + 4); PH_T1(pb + 4); }
        if (IN(pb + 5)) {
            PH_T0(pb + 5);
            const Ctx C = make_ctx(ldsb);
            pg8::Gemm g{XN, (const bf16*)(WSP + WS_W13), M, 2 * DFF, D}; pg8::StaticOrder S; S.init(M, 2 * DFF, C.G, (int)blockIdx.x);
            pg8::EpiSwiGLU E{PROJ, DFF};
            for (int rep = 0; rep < REP_GUP; ++rep)
            pg8::gemm_phase<pg8::EpiSwiGLU, pg8::StaticOrder, true, true>(C.lds, g, S, E);
            SEAM(pb + 5); PH_T1(pb + 5);
        }
        if (IN(pb + 6)) {
            PH_T0(pb + 6);
            const Ctx C = make_ctx(ldsb);
            pg8::Gemm g{PROJ, (const bf16*)(WSP + WS_W2), M, D, DFF}; pg8::StaticOrder S; S.init(M, D, C.G, (int)blockIdx.x);
            pg8::EpiResid E{OUTP, modl + 5120};
            pg8::gemm_phase<pg8::EpiResid, pg8::StaticOrder, true, true>(C.lds, g, S, E);
            SEAM(pb + 6); PH_T1(pb + 6);
        }
        if (l == 0 && IN(9)) { PH_T0(9); const Ctx C = make_ctx(ldsb); convert_weights(C, 1); norm_rows<false>(C, INP(I_N1G) + D, modp + 3 * 6144, 0, 1024); SEAM(9); PH_T1(9); }
#undef IN
#undef SEAM
}
struct Args { const float* in[N_IN]; float* out; unsigned char* ws; int ph_lo, ph_hi; };
constexpr int N_PHASES = 18;
__global__ void __launch_bounds__(NWAVES * 64, 2) mk_fwd(Args args) {
    extern __shared__ __attribute__((aligned(16))) unsigned char lds_raw[];
    LAS unsigned char* const ldsb = (LAS unsigned char*)lds_raw;
    volatile LAS unsigned* MISC = (volatile LAS unsigned*)(ldsb + MISC_OFF);
    for (int u = threadIdx.x; u < (LDS_BYTES - LDSCTL_OFF) / 4; u += NWAVES * 64) ((LAS unsigned*)(ldsb + LDSCTL_OFF))[u] = 0u;
    __syncthreads();
    const int lo = args.ph_lo, hi = args.ph_hi;
    const bool use_bar = (hi - lo) > 1;
    XcdBarrier bar; bar.bar = (unsigned*)(WSP + WS_CTL) + CW_BAR; bar.x = 0; bar.st = nullptr;
    if (use_bar) bar = xcd_barrier_post((unsigned*)(WSP + WS_CTL) + CW_BAR, MISC + 8);
#define IN(k) (lo <= (k) && (k) < hi)
#define SEAM(k) do { if (IN((k) + 1)) xcd_barrier(bar); } while (0)
    float* const modp = (float*)(WSP + WS_MOD);
    bf16* const XN = (bf16*)(WSP + WS_XN); bf16* const PROJ = (bf16*)(WSP + WS_PROJ);

    unsigned long long tacc = 0, tph = 0;
    if (IN(0)) { PH_T0(0); const Ctx C = make_ctx(ldsb); for (int rep = 0; rep < REP_P0; ++rep) { p0_prologue(C); __syncthreads(); } SEAM(0); PH_T1(0); }
    if (IN(1)) { PH_T0(1); const Ctx C = make_ctx(ldsb); for (int rep = 0; rep < REP_P1; ++rep) { norm_rows<true>(C, INP(I_N1G), modp, 0, 1024); hyena_filters(C); __syncthreads(); } SEAM(1); PH_T1(1); }
    layer_phases<0>(ldsb, lo, hi, bar, tacc);
    layer_phases<1>(ldsb, lo, hi, bar, tacc);
    if (IN(17)) { PH_T0(17); const Ctx C = make_ctx(ldsb); final_norm(C); PH_T1(17); }
    if ((PROBE_MASK != 0u || PROBE_SUB != 0u) && blockIdx.x == PROBE_BLK) { const unsigned long long te = __builtin_amdgcn_s_memrealtime(); while (__builtin_amdgcn_s_memrealtime() - te < tacc) __builtin_amdgcn_s_sleep(8); }
#undef IN
#undef SEAM
}

#ifndef MK_N_LAUNCHES
#define MK_N_LAUNCHES 1
#endif
extern "C" void kernel_launch(void* const* d_in, const int* in_sizes, int n_in, void* d_out, int out_size, void* d_ws, size_t ws_size, hipStream_t stream) {
    static int grid = 0;
    if (grid == 0) {
        if (n_in != N_IN || out_size != (int)OUT_END || ws_size < WS_END) { fprintf(stderr, "kernel_launch: unexpected sizes n_in %d out %d ws %zu\n", n_in, out_size, ws_size); grid = -1; return; }
        int dev = 0, cus = 0, per_cu = 0;
        if (hipGetDevice(&dev) != hipSuccess || hipDeviceGetAttribute(&cus, hipDeviceAttributeMultiprocessorCount, dev) != hipSuccess) { grid = -1; return; }
        if (hipFuncSetAttribute((const void*)mk_fwd, hipFuncAttributeMaxDynamicSharedMemorySize, LDS_BYTES) != hipSuccess) { fprintf(stderr, "kernel_launch: hipFuncSetAttribute failed\n"); grid = -1; return; }
        if (hipOccupancyMaxActiveBlocksPerMultiprocessor(&per_cu, (const void*)mk_fwd, NWAVES * 64, LDS_BYTES) != hipSuccess || per_cu < 1) { fprintf(stderr, "kernel_launch: occupancy query says %d blocks per CU\n", per_cu); per_cu = 1; }
        (void)hipGetLastError();
        grid = cus;
    }
    if (grid < 0) return;
    if (hipMemsetAsync((char*)d_ws + WS_CTL, 0, CTL_ZERO_BYTES, stream) != hipSuccess) { fprintf(stderr, "kernel_launch: memset failed\n"); return; }
    Args a{};
    for (int i = 0; i < N_IN; ++i) a.in[i] = (const float*)d_in[i];
    a.out = (float*)d_out; a.ws = (unsigned char*)d_ws;
#if MK_N_LAUNCHES == 1
    a.ph_lo = 0; a.ph_hi = N_PHASES;
    hipLaunchKernelGGL(mk_fwd, dim3(grid), dim3(NWAVES * 64), LDS_BYTES, stream, a);
#else
    for (int p = 0; p < N_PHASES; ++p) { a.ph_lo = p; a.ph_hi = p + 1; hipLaunchKernelGGL(mk_fwd, dim3(grid), dim3(NWAVES * 64), LDS_BYTES, stream, a); }
#endif
    const hipError_t le = hipPeekAtLastError();
    if (le != hipSuccess) fprintf(stderr, "kernel_launch: launch failed: %s\n", hipGetErrorName(le));
}
```
